# Optimizing an MI355X kernel written in HIP

```python
import jax, jax.numpy as jnp
from jax import lax
import numpy as np

D_MODEL = 2048
BATCH = 16
SEQ = 2048
DEPTH = 2

N_A_LAYERS = DEPTH - DEPTH // 2
N_B_LAYERS = DEPTH // 2
PLE_DIM = 256
D_FF = 5632
HG_EXPAND = 128
HG_HEADS = D_MODEL // HG_EXPAND
HG_DK = HG_EXPAND
HG_DV = D_MODEL // HG_HEADS
HG_CHUNK = 32
DA_HEAD_DIM = 128
DA_HEADS = D_MODEL // (2 * DA_HEAD_DIM)
DA_VDIM = 2 * DA_HEAD_DIM
Q_BLOCK = 128
ROPE_THETA = 10000.0
NORM_EPS = 1e-6

kernel_name = "yoco_hgrn2_diffattn_macaron_ple"


def rms_norm(x, g):
    xf = x.astype(jnp.float32)
    y = xf * lax.rsqrt(jnp.mean(xf * xf, axis=-1, keepdims=True) + NORM_EPS)
    return (y * g.astype(jnp.float32)).astype(x.dtype)


def swiglu_ffn(x, w_gate_up, w_down):
    gate, up = jnp.split(x @ w_gate_up, 2, axis=-1)
    return (jax.nn.silu(gate) * up) @ w_down


def rope(x, positions):
    dh = x.shape[-1]
    half = dh // 2
    inv_freq = ROPE_THETA ** (-jnp.arange(0, dh, 2, dtype=jnp.float32) / dh)
    ang = positions.astype(jnp.float32)[:, None] * inv_freq[None, :]
    bshape = (1, x.shape[1]) + (1,) * (x.ndim - 3) + (half,)
    cos = jnp.cos(ang).reshape(bshape)
    sin = jnp.sin(ang).reshape(bshape)
    xf = x.astype(jnp.float32)
    x1, x2 = xf[..., :half], xf[..., half:]
    out = jnp.concatenate([x1 * cos - x2 * sin, x2 * cos + x1 * sin], axis=-1)
    return out.astype(x.dtype)


def hgrn2_mixer(x, w_in, lb, out_gain, w_out):
    B, S, _ = x.shape
    d_f = HG_HEADS * HG_DK
    d_i = HG_HEADS * HG_DV
    proj = x @ w_in
    q = proj[..., :d_f]
    fz = proj[..., d_f:2 * d_f].astype(jnp.float32)
    v_in = proj[..., 2 * d_f:2 * d_f + d_i]
    g = proj[..., 2 * d_f + d_i:]
    lbf = lb.astype(jnp.float32)
    log_f = jnp.logaddexp(jnp.log(lbf), jnp.log1p(-lbf) + jax.nn.log_sigmoid(fz))
    k = (1.0 - lbf) * jax.nn.sigmoid(-fz)

    nc = S // HG_CHUNK

    def to_chunks(t, d):
        return t.reshape(B, nc, HG_CHUNK, HG_HEADS, d).transpose(1, 0, 3, 2, 4)

    qc = to_chunks(q.astype(jnp.float32) * (HG_DK ** -0.5), HG_DK)
    kc = to_chunks(k, HG_DK)
    vc = to_chunks(v_in.astype(jnp.float32), HG_DV)
    bc = jnp.cumsum(to_chunks(log_f, HG_DK), axis=3)
    causal = jnp.tril(jnp.ones((HG_CHUNK, HG_CHUNK), dtype=bool))

    def step(state, inp):
        q_c, k_c, v_c, b_c = inp
        o_inter = jnp.einsum('bhck,bhkv->bhcv', q_c * jnp.exp(b_c), state)
        diff = b_c[:, :, :, None, :] - b_c[:, :, None, :, :]
        decay = jnp.exp(jnp.where(causal[None, None, :, :, None], diff, -jnp.inf))
        attn = jnp.einsum('bhtk,bhsk,bhtsk->bhts', q_c, k_c, decay)
        o_intra = jnp.einsum('bhts,bhsv->bhtv', attn, v_c)
        b_last = b_c[:, :, -1:, :]
        new_state = state * jnp.exp(b_last)[:, :, 0, :, None] + jnp.einsum(
            'bhsk,bhsv->bhkv', k_c * jnp.exp(b_last - b_c), v_c)
        return new_state, o_inter + o_intra

    state0 = jnp.zeros((B, HG_HEADS, HG_DK, HG_DV), jnp.float32)
    _, o = lax.scan(step, state0, (qc, kc, vc, bc))
    o = o.transpose(1, 0, 3, 2, 4).reshape(B, S, HG_HEADS, HG_DV)
    o = rms_norm(o, out_gain).reshape(B, S, d_i).astype(x.dtype)
    o = o * jax.nn.silu(g)
    return o @ w_out


def shared_kv(h, kv_norm, w_kv, positions):
    B, S, _ = h.shape
    kv = rms_norm(h, kv_norm) @ w_kv
    d_k = DA_HEADS * 2 * DA_HEAD_DIM
    k = kv[..., :d_k].reshape(B, S, DA_HEADS, 2, DA_HEAD_DIM)
    v = kv[..., d_k:].reshape(B, S, DA_HEADS, DA_VDIM)
    return rope(k, positions), v


def diff_attention(x, k, v, w_q, lam, subln, w_out, lambda_init, positions):
    B, S, _ = x.shape
    q = (x @ w_q).reshape(B, S, DA_HEADS, 2, DA_HEAD_DIM)
    q = rope(q, positions) * (DA_HEAD_DIM ** -0.5)
    lam32 = lam.astype(jnp.float32)
    lambda_full = (jnp.exp(jnp.sum(lam32[0] * lam32[1])) - jnp.exp(jnp.sum(lam32[2] * lam32[3]))
                   + lambda_init)
    nq = S // Q_BLOCK
    qb = q.reshape(B, nq, Q_BLOCK, DA_HEADS, 2, DA_HEAD_DIM).transpose(1, 0, 2, 3, 4, 5)
    q_pos = positions.reshape(nq, Q_BLOCK)

    def one_block(args):
        q_blk, qp = args
        s = jnp.einsum('bqhcd,bkhcd->bhcqk', q_blk, k).astype(jnp.float32)
        mask = positions[None, :] <= qp[:, None]
        s = jnp.where(mask[None, None, None], s, -jnp.inf)
        pm = jax.nn.softmax(s, axis=-1)
        w = pm[:, :, 0] - lambda_full * pm[:, :, 1]
        return jnp.einsum('bhqk,bkhv->bqhv', w.astype(v.dtype), v)

    o = lax.map(one_block, (qb, q_pos))
    o = o.transpose(1, 0, 2, 3, 4).reshape(B, S, DA_HEADS, DA_VDIM)
    o = rms_norm(o, subln) * (1.0 - lambda_init)
    return o.reshape(B, S, DA_HEADS * DA_VDIM) @ w_out


def setup_inputs(seed: int = 0) -> dict:
    key = jax.random.key(seed)
    ks = jax.random.split(key, 22)
    f32 = jnp.float32

    def nrm(k, shape, scale):
        return jax.random.normal(k, shape, f32) * scale

    def gain(k, shape):
        return 1.0 + 0.02 * jax.random.normal(k, shape, f32)

    d_f = HG_HEADS * HG_DK
    d_i = HG_HEADS * HG_DV
    return {
        "x": nrm(ks[0], (BATCH, SEQ, D_MODEL), 1.0),
        "p": nrm(ks[1], (DEPTH, BATCH, SEQ, PLE_DIM), 1.0),
        "ffn_norm": gain(ks[2], (DEPTH, 2, D_MODEL)),
        "ffn_w_gate_up": nrm(ks[3], (DEPTH, 2, D_MODEL, 2 * D_FF), D_MODEL ** -0.5),
        "ffn_w_down": nrm(ks[4], (DEPTH, 2, D_FF, D_MODEL), D_FF ** -0.5),
        "mix_norm": gain(ks[5], (DEPTH, D_MODEL)),
        "hgrn_w_in": nrm(ks[6], (N_A_LAYERS, D_MODEL, 2 * d_f + 2 * d_i), D_MODEL ** -0.5),
        "hgrn_lower_bounds": nrm(ks[7], (N_A_LAYERS + 1, d_f), 0.5),
        "hgrn_out_norm": gain(ks[8], (N_A_LAYERS, HG_DV)),
        "hgrn_w_out": nrm(ks[9], (N_A_LAYERS, d_i, D_MODEL), d_i ** -0.5),
        "kv_norm": gain(ks[10], (D_MODEL,)),
        "w_kv": nrm(ks[11], (D_MODEL, DA_HEADS * 2 * DA_HEAD_DIM + DA_HEADS * DA_VDIM), D_MODEL ** -0.5),
        "diff_w_q": nrm(ks[12], (N_B_LAYERS, D_MODEL, DA_HEADS * 2 * DA_HEAD_DIM), D_MODEL ** -0.5),
        "diff_lambda": nrm(ks[13], (N_B_LAYERS, 4, DA_HEAD_DIM), 0.1),
        "diff_subln": gain(ks[14], (N_B_LAYERS, DA_VDIM)),
        "diff_w_out": nrm(ks[15], (N_B_LAYERS, DA_HEADS * DA_VDIM, D_MODEL), (DA_HEADS * DA_VDIM) ** -0.5),
        "ple_norm": gain(ks[16], (DEPTH, D_MODEL)),
        "ple_w_gate": nrm(ks[17], (DEPTH, D_MODEL, D_MODEL), D_MODEL ** -0.5),
        "ple_w_proj": nrm(ks[18], (DEPTH, PLE_DIM, D_MODEL), PLE_DIM ** -0.5),
        "final_norm": gain(ks[19], (D_MODEL,)),
    }


def reference(x, p, ffn_norm, ffn_w_gate_up, ffn_w_down, mix_norm, hgrn_w_in, hgrn_lower_bounds,
              hgrn_out_norm, hgrn_w_out, kv_norm, w_kv, diff_w_q, diff_lambda, diff_subln, diff_w_out,
              ple_norm, ple_w_gate, ple_w_proj, final_norm):
    positions = jnp.arange(x.shape[1], dtype=jnp.int32)
    lb_all = jnp.cumsum(jax.nn.softmax(hgrn_lower_bounds.astype(jnp.float32), axis=0), axis=0)
    h = x
    k_shared = None
    v_shared = None
    for i in range(DEPTH):
        h = h + 0.5 * swiglu_ffn(rms_norm(h, ffn_norm[i, 0]), ffn_w_gate_up[i, 0], ffn_w_down[i, 0])
        hn = rms_norm(h, mix_norm[i])
        if i < N_A_LAYERS:
            mix = hgrn2_mixer(hn, hgrn_w_in[i], lb_all[i], hgrn_out_norm[i], hgrn_w_out[i])
        else:
            j = i - N_A_LAYERS
            lambda_init = 0.8 - 0.6 * math_exp(-0.3 * i)
            mix = diff_attention(hn, k_shared, v_shared, diff_w_q[j], diff_lambda[j], diff_subln[j],
                                 diff_w_out[j], lambda_init, positions)
        h = h + mix
        h = h + 0.5 * swiglu_ffn(rms_norm(h, ffn_norm[i, 1]), ffn_w_gate_up[i, 1], ffn_w_down[i, 1])
        gate = jax.nn.sigmoid(rms_norm(h, ple_norm[i]) @ ple_w_gate[i])
        h = h + gate * (p[i] @ ple_w_proj[i])
        if i == N_A_LAYERS - 1:
            k_shared, v_shared = shared_kv(h, kv_norm, w_kv, positions)
    return rms_norm(h, final_norm)


def math_exp(t):
    return float(np.exp(t))
```

```cpp
#include <hip/hip_runtime.h>
#include <hip/hip_bf16.h>
#include <cstdio>
#include <cstdint>

#ifndef PROBE_DUP
#define PROBE_DUP -1
#endif
#ifndef MK_N_LAUNCHES
#define MK_N_LAUNCHES 1
#endif

__device__ __forceinline__ int fresh_lane() { int l; asm volatile("v_mbcnt_lo_u32_b32 %0, -1, 0\n\tv_mbcnt_hi_u32_b32 %0, -1, %0" : "=v"(l)); return l; }
namespace pg8 {
#define PG8_LAS __attribute__((address_space(3)))
typedef unsigned short bf16_t;
typedef short bf16x8 __attribute__((ext_vector_type(8)));
typedef float f32x4 __attribute__((ext_vector_type(4)));
typedef unsigned u32x4 __attribute__((ext_vector_type(4)));
constexpr int BM = 256, BK = 64, HALF = 128, HTB = HALF * BK * 2, STAGE_BYTES = 8 * HTB, NXCD = 8, WGM = 4;

__host__ __device__ __forceinline__ int lds_byte(int r, int c) { const int st = (r >> 4) * 2 + (c >> 5), rr = r & 15, cc = c & 31, ob = rr * 64 + cc * 2; return st * 1024 + (ob ^ (((ob >> 9) & 1) << 5)); }
__host__ __device__ __forceinline__ void stage_rc(int b, int& R, int& C) { const int st = b / 1024, sb = b % 1024, swz = sb ^ (((sb >> 9) & 1) << 5); R = (st >> 1) * 16 + swz / 64; C = (st & 1) * 32 + (swz % 64) / 2; }
__host__ __device__ __forceinline__ int perm32(int rho) { const int n = rho >> 4, i = rho & 15; return 8 * (i >> 2) + 4 * n + (i & 3); }

struct Unit { int pm, pn; };
struct Gemm { const bf16_t* A; const bf16_t* Bt; int M, N, K; };

struct StaticOrder {
    int nM, nN, nwg, G, c;
    __host__ __device__ void init(int M, int N, int G_, int c_) { nM = M / BM; nN = N / BM; nwg = nM * nN; G = G_; c = c_; }
    __host__ __device__ bool next(int i, Unit& u) const {
        const long L = (long)i * G + c; if (L >= nwg) return false;
        int wgid = (int)L; { const int q = nwg / NXCD, r = nwg % NXCD, xcd = wgid % NXCD, off = wgid / NXCD; wgid = (xcd < r ? xcd * (q + 1) : r * (q + 1) + (xcd - r) * q) + off; }
        const int nig = WGM * nN, gid = wgid / nig, fm = gid * WGM, gsz = (nM - fm) < WGM ? (nM - fm) : WGM;
        u.pm = fm + ((wgid % nig) % gsz); u.pn = (wgid % nig) / gsz; return true;
    }
    __device__ __forceinline__ void a_ready(const Unit&) const {}
    __device__ __forceinline__ void done(const Unit&) const {}
};

struct NoPre { __device__ __forceinline__ void operator()() const {} };
template <class Epi, class Sched, bool ALIGN_EPI, bool SP2, bool ATILED = false, bool BTILED = false, class Pre = NoPre>
__device__ __forceinline__ void gemm_phase(PG8_LAS unsigned char* lds, const Gemm g, const Sched& S, const Epi& E, const int wid, const Pre& pre = Pre()) {
    const int lane = fresh_lane(), tid = wid * 64 + lane, wr = wid >> 2, wc = wid & 3, fr = lane & 15, fq = lane >> 4;
    const int K = g.K, nt = K / BK;
    unsigned voffA[2], voffB[2];
#pragma unroll
    for (int i = 0; i < 2; ++i) { int R, C; stage_rc(tid * 16 + i * 8192, R, C); const int Rb = Epi::PERM ? ((R & ~31) + perm32(R & 31)) : R;
        voffA[i] = (unsigned)(R * (ATILED ? BK : K) + C) * 2u; voffB[i] = (unsigned)(Rb * (BTILED ? BK : K) + C) * 2u; }
    const size_t kstepA = ATILED ? (size_t)(BM * BK * 2) : (size_t)(BK * 2), kstepB = BTILED ? (size_t)(BM * BK * 2) : (size_t)(BK * 2);
    const size_t hstepA = ATILED ? (size_t)(HALF * BK * 2) : (size_t)HALF * K * 2, hstepB = BTILED ? (size_t)(HALF * BK * 2) : (size_t)HALF * K * 2;
    const size_t tstep = (size_t)BM * K * 2;
    const unsigned ldsw = (unsigned)wid * 1024u;
    const int aoff = lds_byte(wr * 64 + fr, fq * 8), boff = lds_byte(wc * 32 + fr, fq * 8);
#define PG8_SA(b, h) (((b) * 2 + (h)) * HTB)
#define PG8_SB(b, h) ((4 + (b) * 2 + (h)) * HTB)
#define PG8_STAGE(bufoff, gbase, voff) do { const char* gb_ = (const char*)(gbase); asm volatile("" : "+s"(gb_));        \
        _Pragma("unroll") for (int _i = 0; _i < 2; ++_i) \
        __builtin_amdgcn_global_load_lds((const unsigned*)(gb_ + (voff)[_i]), (PG8_LAS unsigned*)(lds + (bufoff) + ldsw + _i * 8192), 16, 0, 0); } while (0)
#define PG8_LDA(dst, b, h) do { _Pragma("unroll") for (int m = 0; m < 4; ++m) _Pragma("unroll") for (int k = 0; k < 2; ++k) dst[m][k] = *(const PG8_LAS bf16x8*)(lds + PG8_SA(b, h) + aoff + m * 2048 + k * 1024); } while (0)
#define PG8_LDB(dst, b, h) do { _Pragma("unroll") for (int n = 0; n < 2; ++n) _Pragma("unroll") for (int k = 0; k < 2; ++k) dst[n][k] = *(const PG8_LAS bf16x8*)(lds + PG8_SB(b, h) + boff + n * 2048 + k * 1024); } while (0)
#define PG8_MMA(ai, bj, At, Bt) do { __builtin_amdgcn_s_setprio(1); _Pragma("unroll") for (int m = 0; m < 4; ++m) _Pragma("unroll") for (int n = 0; n < 2; ++n) _Pragma("unroll") for (int k = 0; k < 2; ++k) \
        acc[ai][bj][m][n] = __builtin_amdgcn_mfma_f32_16x16x32_bf16(Bt[n][k], At[m][k], acc[ai][bj][m][n], 0, 0, 0); __builtin_amdgcn_s_setprio(0); } while (0)
#define PG8_WAIT_V(n) asm volatile("s_waitcnt vmcnt(" #n ")" ::: "memory")
#define PG8_WAIT_L(n) asm volatile("s_waitcnt lgkmcnt(" #n ")" ::: "memory")
#define PG8_BAR __builtin_amdgcn_s_barrier()
#define PG8_SCHED __builtin_amdgcn_sched_barrier(0)
    Unit cur, nxt; int ui = 0;
    if (!S.next(0, cur)) return;
    f32x4 acc[2][2][4][2];
#pragma unroll
    for (int a = 0; a < 2; ++a)
#pragma unroll
        for (int b = 0; b < 2; ++b)
#pragma unroll
            for (int m = 0; m < 4; ++m)
#pragma unroll
                for (int n = 0; n < 2; ++n) acc[a][b][m][n] = (f32x4){0.f, 0.f, 0.f, 0.f};
    bf16x8 At[4][2], B0[2][2], B1[2][2];
    const char* cA = (const char*)g.A + (size_t)cur.pm * tstep; const char* cB = (const char*)g.Bt + (size_t)cur.pn * tstep;
    S.a_ready(cur);
    if constexpr (SP2) {
        PG8_STAGE(PG8_SB(0, 0), cB, voffB); PG8_STAGE(PG8_SB(0, 1), cB + hstepB, voffB); PG8_STAGE(PG8_SA(0, 0), cA, voffA); PG8_STAGE(PG8_SA(0, 1), cA + hstepA, voffA);
        pre();
        if (wr == 1) PG8_BAR;
        PG8_WAIT_V(2); PG8_BAR;
        PG8_STAGE(PG8_SB(1, 0), cB + kstepB, voffB); PG8_STAGE(PG8_SA(1, 0), cA + kstepA, voffA); PG8_STAGE(PG8_SB(1, 1), cB + hstepB + kstepB, voffB);
        PG8_WAIT_V(6); PG8_BAR;
    } else {
        PG8_STAGE(PG8_SB(0, 0), cB, voffB); PG8_STAGE(PG8_SA(0, 0), cA, voffA); PG8_STAGE(PG8_SB(0, 1), cB + hstepB, voffB); PG8_STAGE(PG8_SA(0, 1), cA + hstepA, voffA);
        if (wr == 1) PG8_BAR;
        PG8_WAIT_V(4); PG8_BAR;
        PG8_STAGE(PG8_SB(1, 0), cB + kstepB, voffB); PG8_STAGE(PG8_SA(1, 0), cA + kstepA, voffA); PG8_STAGE(PG8_SB(1, 1), cB + hstepB + kstepB, voffB);
        PG8_WAIT_V(6); PG8_BAR;
    }
    for (;;) {
        const bool has_next = S.next(ui + 1, nxt);
        const char* nA = has_next ? (const char*)g.A + (size_t)nxt.pm * tstep : cA; const char* nB = has_next ? (const char*)g.Bt + (size_t)nxt.pn * tstep : cB;
#pragma clang loop unroll(disable)
        for (int t = 0; t < nt; t += 2) {
            const bool last = (t == nt - 2);
            const char* a1 = cA + (size_t)(t + 1) * kstepA;
            const char* a2 = last ? nA : cA + (size_t)(t + 2) * kstepA; const char* b2 = last ? nB : cB + (size_t)(t + 2) * kstepB;
            const char* a3 = a2 + kstepA; const char* b3 = b2 + kstepB;
            if (last && has_next) S.a_ready(nxt);
            if constexpr (SP2) {
            asm volatile("" : "+v"(voffA[0]), "+v"(voffA[1]), "+v"(voffB[0]), "+v"(voffB[1]));
            PG8_LDB(B0, 0, 0); PG8_LDB(B1, 0, 1); PG8_SCHED; PG8_LDA(At, 0, 0); PG8_STAGE(PG8_SA(1, 1), a1 + hstepA, voffA);
            PG8_WAIT_V(8); PG8_WAIT_L(0); PG8_BAR; PG8_MMA(0, 0, At, B0); PG8_MMA(0, 1, At, B1); PG8_BAR; PG8_SCHED;
            PG8_LDA(At, 0, 1); PG8_STAGE(PG8_SB(0, 0), b2, voffB); PG8_STAGE(PG8_SB(0, 1), b2 + hstepB, voffB); PG8_STAGE(PG8_SA(0, 0), a2, voffA);
            PG8_WAIT_V(8); PG8_WAIT_L(0); PG8_BAR; PG8_MMA(1, 0, At, B0); PG8_MMA(1, 1, At, B1); PG8_BAR; PG8_SCHED;
            PG8_LDB(B0, 1, 0); PG8_LDB(B1, 1, 1); PG8_SCHED; PG8_LDA(At, 1, 0); PG8_STAGE(PG8_SA(0, 1), a2 + hstepA, voffA);
            PG8_WAIT_V(8); PG8_WAIT_L(0); PG8_BAR; PG8_MMA(0, 0, At, B0); PG8_MMA(0, 1, At, B1); PG8_BAR; PG8_SCHED;
            PG8_LDA(At, 1, 1); PG8_STAGE(PG8_SB(1, 0), b3, voffB); PG8_STAGE(PG8_SB(1, 1), b3 + hstepB, voffB); PG8_STAGE(PG8_SA(1, 0), a3, voffA);
            PG8_WAIT_V(8); PG8_WAIT_L(0); PG8_BAR; PG8_MMA(1, 0, At, B0); PG8_MMA(1, 1, At, B1); PG8_BAR; PG8_SCHED;
            } else {
            PG8_LDB(B0, 0, 0); PG8_SCHED; PG8_LDA(At, 0, 0); PG8_STAGE(PG8_SA(1, 1), a1 + hstepA, voffA);
            PG8_WAIT_L(8); PG8_BAR; PG8_WAIT_L(0); PG8_MMA(0, 0, At, B0); PG8_BAR; PG8_SCHED;
            PG8_LDB(B1, 0, 1); PG8_STAGE(PG8_SB(0, 0), b2, voffB);
            PG8_BAR; PG8_WAIT_L(0); PG8_MMA(0, 1, At, B1); PG8_BAR;
            PG8_LDA(At, 0, 1); PG8_STAGE(PG8_SA(0, 0), a2, voffA);
            PG8_BAR; PG8_WAIT_L(0); PG8_MMA(1, 0, At, B0); PG8_BAR; PG8_SCHED;
            PG8_STAGE(PG8_SB(0, 1), b2 + hstepB, voffB);
            PG8_WAIT_V(6); PG8_BAR; PG8_MMA(1, 1, At, B1); PG8_BAR;
            PG8_LDB(B0, 1, 0); PG8_SCHED; PG8_LDA(At, 1, 0); PG8_STAGE(PG8_SA(0, 1), a2 + hstepA, voffA);
            PG8_WAIT_L(8); PG8_BAR; PG8_WAIT_L(0); PG8_MMA(0, 0, At, B0); PG8_BAR; PG8_SCHED;
            PG8_LDB(B1, 1, 1); PG8_STAGE(PG8_SB(1, 0), b3, voffB);
            PG8_BAR; PG8_WAIT_L(0); PG8_MMA(0, 1, At, B1); PG8_BAR;
            PG8_LDA(At, 1, 1); PG8_STAGE(PG8_SA(1, 0), a3, voffA);
            PG8_BAR; PG8_WAIT_L(0); PG8_MMA(1, 0, At, B0); PG8_BAR; PG8_SCHED;
            PG8_STAGE(PG8_SB(1, 1), b3 + hstepB, voffB);
            PG8_WAIT_V(6); PG8_BAR; PG8_MMA(1, 1, At, B1); PG8_BAR;
            }
        }
        if constexpr (ALIGN_EPI) { if (wr == 0) PG8_BAR; }
        E(acc, cur, wr, wc, fr, fq); S.done(cur);
        if (!has_next) break;
#pragma unroll
        for (int a = 0; a < 2; ++a)
#pragma unroll
            for (int b = 0; b < 2; ++b)
#pragma unroll
                for (int m = 0; m < 4; ++m)
#pragma unroll
                    for (int n = 0; n < 2; ++n) acc[a][b][m][n] = (f32x4){0.f, 0.f, 0.f, 0.f};
        cur = nxt; cA = nA; cB = nB; ++ui;
        if constexpr (ALIGN_EPI) { if (wr == 1) PG8_BAR; }
    }
    PG8_WAIT_V(0);
    if constexpr (!ALIGN_EPI) { if (wr == 0) PG8_BAR; }
    PG8_BAR;
#undef PG8_SA
#undef PG8_SB
#undef PG8_STAGE
#undef PG8_LDA
#undef PG8_LDB
#undef PG8_MMA
#undef PG8_WAIT_V
#undef PG8_WAIT_L
#undef PG8_BAR
#undef PG8_SCHED
}
}

constexpr int NWAVES = 8;
constexpr int MTOK = 32768, DM = 2048, DFF = 5632, NGU = 2 * DFF, SEQ = 2048, NBATCH = 16;
constexpr float NORM_EPS = 1e-6f;
constexpr float LAMBDA_INIT = 0.35550906759096926f;
constexpr float QSCALE = 0.08838834764831845f;
constexpr size_t MiB = (size_t)1 << 20;
constexpr size_t WS_CTL = 0, CTL_ZERO_BYTES = 32768;
constexpr size_t WS_TAB = 4 * MiB;
constexpr size_t WS_W = 8 * MiB;
constexpr size_t W_GU = 0, W_DN = 176 * MiB, W_HIN = 264 * MiB, W_HOUT = 296 * MiB, W_KV = 304 * MiB, W_Q = 320 * MiB, W_AO = 328 * MiB, W_PG = 336 * MiB, W_PP = 352 * MiB;
constexpr size_t WS_PB = 364 * MiB;
constexpr size_t WS_HB1 = 396 * MiB, WS_HB2 = 524 * MiB;
constexpr size_t WS_BIG = 652 * MiB;
constexpr size_t WS_STATS = WS_BIG + 640 * MiB;
constexpr size_t WS_END = WS_STATS + 9 * MiB;
constexpr size_t BIG_HID = 0;
constexpr size_t BIG_HQ = 0, BIG_HV = 128 * MiB, BIG_HSG = 256 * MiB, BIG_HLF = 384 * MiB;
constexpr size_t BIG_PP = 384 * MiB;
constexpr size_t BIG_KR = 384 * MiB, BIG_VV = 512 * MiB;
constexpr size_t BIG_QR = 0, BIG_O1 = 128 * MiB, BIG_O2 = 256 * MiB;
constexpr int CW_TMO = 0, CW_CODE = 1, CW_BAR = 4096;

constexpr int RING_OFF = 0, RING_BYTES = 131072;
constexpr int RSTAB_OFF = 131072;
constexpr int LDSCTL_OFF = 147456, MISC_OFF = LDSCTL_OFF + 320;
constexpr int RED_OFF = 148480;
constexpr int LDS_BYTES = 152576;

#define GAS __attribute__((address_space(1)))
#define LAS __attribute__((address_space(3)))
typedef unsigned short bf16;
typedef unsigned v4u __attribute__((ext_vector_type(4)));
typedef unsigned v2u __attribute__((ext_vector_type(2)));
typedef float f32x4 __attribute__((ext_vector_type(4)));
typedef short bf16x8 __attribute__((ext_vector_type(8)));
typedef short s16x4 __attribute__((ext_vector_type(4)));
typedef float f32x2_t __attribute__((ext_vector_type(2)));
typedef __bf16 bf16x2_t __attribute__((ext_vector_type(2)));
typedef GAS unsigned gu32;
typedef unsigned long long u64;
#define RLX_AGENT __ATOMIC_RELAXED, __HIP_MEMORY_SCOPE_AGENT
#define LDS_WAIT() asm volatile("s_waitcnt lgkmcnt(0)" ::: "memory")
#define VM_WAIT() asm volatile("s_waitcnt vmcnt(0)" ::: "memory")
__device__ __forceinline__ unsigned pk2(float lo, float hi) { f32x2_t v = {lo, hi}; bf16x2_t b = __builtin_convertvector(v, bf16x2_t); return __builtin_bit_cast(unsigned, b); }
__device__ __forceinline__ float bf2f(unsigned short b) { return __uint_as_float(((unsigned)b) << 16); }
__device__ __forceinline__ float bflo(unsigned w) { return __uint_as_float(w << 16); }
__device__ __forceinline__ float bfhi(unsigned w) { return __uint_as_float(w & 0xffff0000u); }
__device__ __forceinline__ float fast_sigmoid(float x) { return __builtin_amdgcn_rcpf(1.0f + __builtin_amdgcn_exp2f(-1.4426950408889634f * x)); }
__device__ __forceinline__ float wave_sum(float v) {
#pragma unroll
    for (int o = 1; o < 64; o <<= 1) v += __shfl_xor(v, o);
    return v;
}
__device__ __forceinline__ float stat_rstd(const float* st, int row) {
    float s = 0.f;
#pragma unroll
    for (int p = 0; p < 8; ++p) s += st[(size_t)p * MTOK + row];
    return rsqrtf(s * (1.0f / (float)DM) + NORM_EPS);
}
__device__ __forceinline__ void fill_rstd_table(LAS float* tab, const float* st, int c, int wid) {
    const int tid = wid * 64 + fresh_lane(), base = 4096 * (c & 7);
    float r[8];
#pragma unroll
    for (int i = 0; i < 8; ++i) r[i] = stat_rstd(st, base + tid + 512 * i);
#pragma unroll
    for (int i = 0; i < 8; ++i) tab[tid + 512 * i] = r[i];
    asm volatile("s_waitcnt lgkmcnt(0)" ::: "memory"); __syncthreads();
}
struct FillPre { LAS float* tab; const float* st; int c; int wid; __device__ __forceinline__ void operator()() const { fill_rstd_table(tab, st, c, wid); } };
#define XB_TMO      128
#define XB_XCNT(j)  (256  + 64 * (j))
#define XB_XSUB(j)  (1280 + 64 * (j))
#define XB_XGEN(j)  (2304 + 64 * (j))
#define XB_TOP      3328
#define XB_TOPGEN   3392
#define XCD_BAR_WORDS 3456
#define XB_SPIN_CAP (1u << 18)
__device__ __forceinline__ unsigned xb_ld(unsigned* p)              { return __hip_atomic_load(p, __ATOMIC_RELAXED, __HIP_MEMORY_SCOPE_AGENT); }
__device__ __forceinline__ unsigned xb_add(unsigned* p, unsigned v) { return __hip_atomic_fetch_add(p, v, __ATOMIC_RELAXED, __HIP_MEMORY_SCOPE_AGENT); }
__device__ __forceinline__ unsigned xb_xcc_id() { return (unsigned)__builtin_amdgcn_s_getreg((3 << 11) | 20) & 0xFu; }
#define XB_SPIN(cond, bar) do { unsigned _sp = 0; while (cond) { __builtin_amdgcn_s_sleep(1); \
    if ((++_sp & 255u) == 0u) { if (xb_ld(&(bar)[XB_TMO])) break; if (_sp > XB_SPIN_CAP) { atomicAdd(&(bar)[XB_TMO], 1u); break; } } } } while (0)
struct XcdBarrier { unsigned* bar; unsigned x; volatile LAS unsigned* st; };
__device__ __forceinline__ XcdBarrier xcd_barrier_post(unsigned* bar, volatile LAS unsigned* st, int wid) {
    XcdBarrier b; b.bar = bar; b.x = xb_xcc_id(); b.st = st;
    if (wid == 0 && fresh_lane() == 0) (void)xb_add(&bar[XB_XCNT(b.x)], 1u);
    return b;
}
__device__ __forceinline__ void xcd_barrier_complete(unsigned* bar, unsigned x, unsigned& nloc, unsigned& nx) {
    const unsigned G = gridDim.x * gridDim.y * gridDim.z;
    unsigned sum, cnt, mine, sp = 0u;
    for (;;) {
        sum = 0u; cnt = 0u; mine = 0u;
#pragma unroll
        for (unsigned j = 0; j < 16; ++j) { const unsigned c = xb_ld(&bar[XB_XCNT(j)]); sum += c; cnt += (c > 0u) ? 1u : 0u; mine = (j == x) ? c : mine; }
        if (sum == G) break;
        __builtin_amdgcn_s_sleep(1);
        if ((++sp & 255u) == 0u) { if (xb_ld(&bar[XB_TMO])) break; if (sp > XB_SPIN_CAP) { atomicAdd(&bar[XB_TMO], 1u); break; } }
    }
    nloc = mine > 0u ? mine : 1u; nx = cnt > 0u ? cnt : 1u;
}
__device__ __forceinline__ void xcd_barrier(const XcdBarrier& b, int wid) {
    asm volatile("s_waitcnt vmcnt(0)" ::: "memory");
    __syncthreads();
    if (wid == 0 && fresh_lane() == 0) {
        unsigned* bar = b.bar;
        __builtin_amdgcn_s_waitcnt(0);
        unsigned nloc = b.st[0], nx = b.st[1];
        if (nloc == 0u) { xcd_barrier_complete(bar, b.x, nloc, nx); b.st[0] = nloc; b.st[1] = nx; }
        const unsigned old = xb_add(&bar[XB_XSUB(b.x)], 1u);
        const unsigned gen = old / nloc;
        if (old + 1u == (gen + 1u) * nloc) {
            __builtin_amdgcn_fence(__ATOMIC_RELEASE, "agent");
            asm volatile("s_waitcnt vmcnt(0)" ::: "memory");
            const unsigned og = xb_add(&bar[XB_TOP], 1u);
            const unsigned tg = og / nx;
            if (og + 1u == (tg + 1u) * nx) xb_add(&bar[XB_TOPGEN], 1u);
            else XB_SPIN(xb_ld(&bar[XB_TOPGEN]) == tg, bar);
            __builtin_amdgcn_fence(__ATOMIC_ACQUIRE, "agent");
            xb_add(&bar[XB_XGEN(b.x)], 1u);
            asm volatile("s_waitcnt vmcnt(0)" ::: "memory");
        } else {
            XB_SPIN(xb_ld(&bar[XB_XGEN(b.x)]) == gen, bar);
            __builtin_amdgcn_fence(__ATOMIC_ACQUIRE, "agent");
            asm volatile("s_waitcnt vmcnt(0)" ::: "memory");
        }
    }
    __syncthreads();
}

__device__ __forceinline__ float scan16(float x) {
    x += __builtin_bit_cast(float, __builtin_amdgcn_update_dpp(0, __builtin_bit_cast(int, x), 0x111, 0xf, 0xf, true));
    x += __builtin_bit_cast(float, __builtin_amdgcn_update_dpp(0, __builtin_bit_cast(int, x), 0x112, 0xf, 0xf, true));
    x += __builtin_bit_cast(float, __builtin_amdgcn_update_dpp(0, __builtin_bit_cast(int, x), 0x114, 0xf, 0xf, true));
    x += __builtin_bit_cast(float, __builtin_amdgcn_update_dpp(0, __builtin_bit_cast(int, x), 0x118, 0xf, 0xf, true));
    return x;
}
__device__ __forceinline__ float rowsum16(float x) {
    x += __builtin_bit_cast(float, __builtin_amdgcn_update_dpp(0, __builtin_bit_cast(int, x), 0xB1, 0xf, 0xf, true));
    x += __builtin_bit_cast(float, __builtin_amdgcn_update_dpp(0, __builtin_bit_cast(int, x), 0x4E, 0xf, 0xf, true));
    x += __builtin_bit_cast(float, __builtin_amdgcn_update_dpp(0, __builtin_bit_cast(int, x), 0x141, 0xf, 0xf, true));
    x += __builtin_bit_cast(float, __builtin_amdgcn_update_dpp(0, __builtin_bit_cast(int, x), 0x140, 0xf, 0xf, true));
    return x;
}
using pg8::Unit;
struct EpiGU {
    static constexpr bool PERM = true;
    bf16* HID; const LAS float* rt;
    __device__ __forceinline__ void operator()(const f32x4 (&acc)[2][2][4][2], const Unit& u, int wr, int wc, int fr, int fq) const {
        const int row0 = u.pm * 256 + wr * 64 + fr, hc = u.pn * 128 + wc * 32 + 8 * fq;
        float rsv[2][4];
#pragma unroll
        for (int ai = 0; ai < 2; ++ai)
#pragma unroll
            for (int m = 0; m < 4; ++m) rsv[ai][m] = rt[(row0 + ai * 128 + m * 16) & 4095];
#pragma unroll
        for (int ai = 0; ai < 2; ++ai)
#pragma unroll
            for (int m = 0; m < 4; ++m) { const int row = row0 + ai * 128 + m * 16; const float rs = rsv[ai][m], rs2 = rs * rs, rsl = -1.4426950408889634f * rs;
                float h[8];
#pragma unroll
                for (int n = 0; n < 2; ++n)
#pragma unroll
                    for (int j = 0; j < 4; ++j) { const float ga = acc[ai][0][m][n][j], ua = acc[ai][1][m][n][j];
                        h[4 * n + j] = (ga * ua) * rs2 * __builtin_amdgcn_rcpf(1.0f + __builtin_amdgcn_exp2f(ga * rsl)); }
                v4u w; w.x = pk2(h[0], h[1]); w.y = pk2(h[2], h[3]); w.z = pk2(h[4], h[5]); w.w = pk2(h[6], h[7]);
                __builtin_nontemporal_store(w, (v4u*)(HID + (size_t)(row >> 8) * (256 * DFF) + (size_t)(hc >> 6) * 16384 + (row & 255) * 64 + (hc & 63))); }
    }
};
__device__ __forceinline__ void row_stat_store(LAS float* red, float* st, const Unit& u, int wr, int wc, int fr, int fq, const float (&part)[2][4]) {
    if (fq == 0) {
#pragma unroll
        for (int ai = 0; ai < 2; ++ai)
#pragma unroll
            for (int m = 0; m < 4; ++m) red[wc * 256 + ai * 128 + wr * 64 + m * 16 + fr] = part[ai][m];
    }
    asm volatile("s_waitcnt lgkmcnt(0)" ::: "memory"); __builtin_amdgcn_s_barrier(); asm volatile("" ::: "memory");
    const int t = (wr * 4 + wc) * 64 + fq * 16 + fr;
    if (t < 256) { const float sum = (red[t] + red[256 + t]) + (red[512 + t] + red[768 + t]); st[(size_t)u.pn * MTOK + u.pm * 256 + t] = sum; }
}
template <bool F32BASE> struct EpiRes {
    static constexpr bool PERM = true;
    const void* basep; bf16* HB; float* st; float alpha; LAS float* red;
    __device__ __forceinline__ void operator()(const f32x4 (&acc)[2][2][4][2], const Unit& u, int wr, int wc, int fr, int fq) const {
        const int row0 = u.pm * 256 + wr * 64 + fr, c0 = u.pn * 256 + wc * 32 + 8 * fq;
        float part[2][4];
        constexpr int NB = F32BASE ? 2 : 4, NG = 8 / NB, GPA = 4 / NB;
        v4u raw[2][NB][2]; f32x4 bf[2][NB][2][2];
#define RES_LOAD(g, sl) do { _Pragma("unroll") for (int mm = 0; mm < NB; ++mm) { const size_t off = (size_t)(row0 + ((g) / GPA) * 128 + (((g) % GPA) * NB + mm) * 16) * DM + c0; \
            _Pragma("unroll") for (int bj = 0; bj < 2; ++bj) { \
                if constexpr (F32BASE) { const float* base = (const float*)basep; bf[sl][mm][bj][0] = *(const f32x4*)(base + off + bj * 128); bf[sl][mm][bj][1] = *(const f32x4*)(base + off + bj * 128 + 4); } \
                else raw[sl][mm][bj] = *(const v4u*)((const bf16*)basep + off + bj * 128); } } } while (0)
        RES_LOAD(0, 0);
#pragma unroll
        for (int g = 0; g < NG; ++g) { const int ai = g / GPA, mb = g % GPA, sl = g & 1;
            if (g + 1 < NG) RES_LOAD(g + 1, (g + 1) & 1);
#pragma unroll
            for (int mm = 0; mm < NB; ++mm) { const int m = mb * NB + mm; const int row = row0 + ai * 128 + m * 16; const size_t off = (size_t)row * DM + c0; float ss = 0.f;
#pragma unroll
                for (int bj = 0; bj < 2; ++bj) { f32x4 b0, b1;
                    if constexpr (F32BASE) { b0 = bf[sl][mm][bj][0]; b1 = bf[sl][mm][bj][1]; }
                    else { const v4u r = raw[sl][mm][bj]; b0 = (f32x4){bflo(r.x), bfhi(r.x), bflo(r.y), bfhi(r.y)}; b1 = (f32x4){bflo(r.z), bfhi(r.z), bflo(r.w), bfhi(r.w)}; }
                    const f32x4 v0 = b0 + alpha * acc[ai][bj][m][0], v1 = b1 + alpha * acc[ai][bj][m][1];
                    v4u w; w.x = pk2(v0[0], v0[1]); w.y = pk2(v0[2], v0[3]); w.z = pk2(v1[0], v1[1]); w.w = pk2(v1[2], v1[3]);
                    *(v4u*)(HB + off + bj * 128) = w;
                    ss += (v0[0] * v0[0] + v0[1] * v0[1]) + (v0[2] * v0[2] + v0[3] * v0[3]) + (v1[0] * v1[0] + v1[1] * v1[1]) + (v1[2] * v1[2] + v1[3] * v1[3]); }
                ss += __shfl_xor(ss, 16); ss += __shfl_xor(ss, 32); part[ai][m] = ss; }
            asm volatile("" ::: "memory"); }
#undef RES_LOAD
        row_stat_store(red, st, u, wr, wc, fr, fq, part);
    }
};
struct EpiPleG {
    static constexpr bool PERM = true;
    const bf16* base; bf16* HB; float* st; const LAS float* rt; const bf16* PP; LAS float* red;
    __device__ __forceinline__ void operator()(const f32x4 (&acc)[2][2][4][2], const Unit& u, int wr, int wc, int fr, int fq) const {
        const int row0 = u.pm * 256 + wr * 64 + fr, c0 = u.pn * 256 + wc * 32 + 8 * fq;
        float part[2][4];
        v4u bv[2][2][2], pv[2][2][2];
#define PG_LOAD(g, sl) do { _Pragma("unroll") for (int mm = 0; mm < 2; ++mm) { const int row = row0 + ((g) >> 1) * 128 + (2 * ((g) & 1) + mm) * 16; const size_t off = (size_t)row * DM + c0; \
            _Pragma("unroll") for (int bj = 0; bj < 2; ++bj) { bv[sl][mm][bj] = *(const v4u*)(base + off + bj * 128); pv[sl][mm][bj] = *(const v4u*)(PP + off + bj * 128); } } } while (0)
        PG_LOAD(0, 0);
#pragma unroll
        for (int g = 0; g < 4; ++g) { const int ai = g >> 1, mb = g & 1, sl = g & 1;
            if (g + 1 < 4) PG_LOAD(g + 1, (g + 1) & 1);
#pragma unroll
            for (int mm = 0; mm < 2; ++mm) { const int m = 2 * mb + mm; const int row = row0 + ai * 128 + m * 16; const size_t off = (size_t)row * DM + c0; float ss = 0.f;
                const float rs = rt[row & 4095];
#pragma unroll
                for (int bj = 0; bj < 2; ++bj) { const v4u b = bv[sl][mm][bj], p = pv[sl][mm][bj];
                    const float bb[8] = {bflo(b.x), bfhi(b.x), bflo(b.y), bfhi(b.y), bflo(b.z), bfhi(b.z), bflo(b.w), bfhi(b.w)};
                    const float pp[8] = {bflo(p.x), bfhi(p.x), bflo(p.y), bfhi(p.y), bflo(p.z), bfhi(p.z), bflo(p.w), bfhi(p.w)};
                    float v[8];
#pragma unroll
                    for (int n = 0; n < 2; ++n)
#pragma unroll
                        for (int j = 0; j < 4; ++j) { v[4 * n + j] = bb[4 * n + j] + fast_sigmoid(acc[ai][bj][m][n][j] * rs) * pp[4 * n + j]; ss += v[4 * n + j] * v[4 * n + j]; }
                    v4u w; w.x = pk2(v[0], v[1]); w.y = pk2(v[2], v[3]); w.z = pk2(v[4], v[5]); w.w = pk2(v[6], v[7]);
                    *(v4u*)(HB + off + bj * 128) = w; }
                ss += __shfl_xor(ss, 16); ss += __shfl_xor(ss, 32); part[ai][m] = ss; }
            asm volatile("" ::: "memory"); }
#undef PG_LOAD
        row_stat_store(red, st, u, wr, wc, fr, fq, part);
    }
};
struct EpiPlain {
    static constexpr bool PERM = true;
    bf16* C;
    __device__ __forceinline__ void operator()(const f32x4 (&acc)[2][2][4][2], const Unit& u, int wr, int wc, int fr, int fq) const {
        const int row0 = u.pm * 256 + wr * 64 + fr, c0 = u.pn * 256 + wc * 32 + 8 * fq;
#pragma unroll
        for (int ai = 0; ai < 2; ++ai)
#pragma unroll
            for (int m = 0; m < 4; ++m) { bf16* rp = C + (size_t)(row0 + ai * 128 + m * 16) * DM + c0;
#pragma unroll
                for (int bj = 0; bj < 2; ++bj) { const f32x4 a = acc[ai][bj][m][0], b = acc[ai][bj][m][1];
                    v4u w; w.x = pk2(a[0], a[1]); w.y = pk2(a[2], a[3]); w.z = pk2(b[0], b[1]); w.w = pk2(b[2], b[3]);
                    *(v4u*)(rp + bj * 128) = w; } }
    }
};
struct EpiHgIn {
    static constexpr bool PERM = true;
    bf16* Q; float* LF; bf16* V; bf16* SG; const LAS float* rt; const float* lb;
    __device__ __forceinline__ void operator()(const f32x4 (&acc)[2][2][4][2], const Unit& u, int wr, int wc, int fr, int fq) const {
        const int region = u.pn >> 3; const int row0 = u.pm * 256 + wr * 64 + fr, c0 = (u.pn & 7) * 256 + wc * 32 + 8 * fq;
        float rsv[2][4];
#pragma unroll
        for (int ai = 0; ai < 2; ++ai)
#pragma unroll
            for (int m = 0; m < 4; ++m) rsv[ai][m] = rt[(row0 + ai * 128 + m * 16) & 4095];
        if (region == 1) {
            f32x4 lbv[2][2];
#pragma unroll
            for (int bj = 0; bj < 2; ++bj) { lbv[bj][0] = *(const f32x4*)(lb + c0 + bj * 128); lbv[bj][1] = *(const f32x4*)(lb + c0 + bj * 128 + 4); }
#pragma unroll
            for (int ai = 0; ai < 2; ++ai)
#pragma unroll
                for (int mp = 0; mp < 2; ++mp) { const int rowa = row0 + ai * 128 + (2 * mp) * 16, rowb = rowa + 16; const float rsa = rsv[ai][2 * mp], rsb = rsv[ai][2 * mp + 1];
#pragma unroll
                    for (int bj = 0; bj < 2; ++bj) { float xa[8], xb[8];
#pragma unroll
                        for (int n = 0; n < 2; ++n)
#pragma unroll
                            for (int j = 0; j < 4; ++j) { const float l = lbv[bj][n][j], om = 1.0f - l;
                                const float sa = fast_sigmoid(acc[ai][bj][2 * mp][n][j] * rsa), sb = fast_sigmoid(acc[ai][bj][2 * mp + 1][n][j] * rsb);
                                xa[4 * n + j] = __logf(l + om * sa); xb[4 * n + j] = __logf(l + om * sb); }
#pragma unroll
                        for (int e = 0; e < 8; ++e) { const float ta = rowsum16(xa[e]); xa[e] = scan16(xa[e]); xb[e] = scan16(xb[e]) + ta; }
                        float* pa = LF + (size_t)rowa * DM + c0 + bj * 128; float* pb = LF + (size_t)rowb * DM + c0 + bj * 128;
                        __builtin_nontemporal_store((f32x4){xa[0], xa[1], xa[2], xa[3]}, (f32x4*)pa); __builtin_nontemporal_store((f32x4){xa[4], xa[5], xa[6], xa[7]}, (f32x4*)(pa + 4));
                        __builtin_nontemporal_store((f32x4){xb[0], xb[1], xb[2], xb[3]}, (f32x4*)pb); __builtin_nontemporal_store((f32x4){xb[4], xb[5], xb[6], xb[7]}, (f32x4*)(pb + 4));
 } }
        } else {
            const size_t roff = region == 0 ? 0 : (region == 2 ? (size_t)(BIG_HV - BIG_HQ) : (size_t)(BIG_HSG - BIG_HQ));
            bf16* O = (bf16*)((unsigned char*)Q + roff);
#pragma unroll
            for (int ai = 0; ai < 2; ++ai)
#pragma unroll
                for (int m = 0; m < 4; ++m) { const int row = row0 + ai * 128 + m * 16; const float rs = rsv[ai][m]; bf16* rp = O + (size_t)row * DM + c0;
#pragma unroll
                    for (int bj = 0; bj < 2; ++bj) { float h[8];
#pragma unroll
                        for (int n = 0; n < 2; ++n)
#pragma unroll
                            for (int j = 0; j < 4; ++j) { float x = acc[ai][bj][m][n][j] * rs; if (region == 3) x = x * fast_sigmoid(x); h[4 * n + j] = x; }
                        v4u w; w.x = pk2(h[0], h[1]); w.y = pk2(h[2], h[3]); w.z = pk2(h[4], h[5]); w.w = pk2(h[6], h[7]);
                        __builtin_nontemporal_store(w, (v4u*)(rp + bj * 128)); } }
        }
    }
};
struct EpiRope {
    static constexpr bool PERM = true;
    bf16* O; bf16* V2; int nrope; const LAS float* rt; const float* cs; const float* sn;
    __device__ __forceinline__ void operator()(const f32x4 (&acc)[2][2][4][2], const Unit& u, int wr, int wc, int fr, int fq) const {
        const int row0 = u.pm * 256 + wr * 64 + fr;
        float rsv[2][4];
#pragma unroll
        for (int ai = 0; ai < 2; ++ai)
#pragma unroll
            for (int m = 0; m < 4; ++m) rsv[ai][m] = rt[(row0 + ai * 128 + m * 16) & 4095];
        if (u.pn < nrope) {
            const int comp = wc >> 1, dl = 32 * (wc & 1) + 8 * fq, oc = u.pn * 256 + comp * 128 + dl;
            f32x4 cv[2][2][2], sv[2][2][2];
#define ROPE_LOAD(g, sl) do { _Pragma("unroll") for (int mm = 0; mm < 2; ++mm) { const int pos = (row0 + ((g) >> 1) * 128 + (2 * ((g) & 1) + mm) * 16) & (SEQ - 1); \
            _Pragma("unroll") for (int n = 0; n < 2; ++n) { cv[sl][mm][n] = *(const f32x4*)(cs + pos * 64 + dl + 4 * n); sv[sl][mm][n] = *(const f32x4*)(sn + pos * 64 + dl + 4 * n); } } } while (0)
            ROPE_LOAD(0, 0);
#pragma unroll
            for (int g = 0; g < 4; ++g) { const int ai = g >> 1, sl = g & 1;
                if (g + 1 < 4) ROPE_LOAD(g + 1, (g + 1) & 1);
#pragma unroll
                for (int mm = 0; mm < 2; ++mm) { const int m = 2 * (g & 1) + mm; const int row = row0 + ai * 128 + m * 16; const float rs = rsv[ai][m];
                    float o1[8], o2[8];
#pragma unroll
                    for (int n = 0; n < 2; ++n) {
#pragma unroll
                        for (int j = 0; j < 4; ++j) { const float x1 = acc[ai][0][m][n][j] * rs, x2 = acc[ai][1][m][n][j] * rs; const float c = cv[sl][mm][n][j], sj = sv[sl][mm][n][j]; o1[4 * n + j] = x1 * c - x2 * sj; o2[4 * n + j] = x2 * c + x1 * sj; } }
                    v4u w1, w2; w1.x = pk2(o1[0], o1[1]); w1.y = pk2(o1[2], o1[3]); w1.z = pk2(o1[4], o1[5]); w1.w = pk2(o1[6], o1[7]);
                    w2.x = pk2(o2[0], o2[1]); w2.y = pk2(o2[2], o2[3]); w2.z = pk2(o2[4], o2[5]); w2.w = pk2(o2[6], o2[7]);
                    bf16* rp = O + (size_t)row * DM + oc; __builtin_nontemporal_store(w1, (v4u*)rp); __builtin_nontemporal_store(w2, (v4u*)(rp + 64)); }
                asm volatile("" ::: "memory"); }
#undef ROPE_LOAD
        } else {
            const int c0 = (u.pn - nrope) * 256 + wc * 32 + 8 * fq;
#pragma unroll
            for (int ai = 0; ai < 2; ++ai)
#pragma unroll
                for (int m = 0; m < 4; ++m) { const int row = row0 + ai * 128 + m * 16; const float rs = rsv[ai][m]; bf16* rp = V2 + (size_t)row * DM + c0;
#pragma unroll
                    for (int bj = 0; bj < 2; ++bj) { const f32x4 a = acc[ai][bj][m][0] * rs, b = acc[ai][bj][m][1] * rs;
                        v4u w; w.x = pk2(a[0], a[1]); w.y = pk2(a[2], a[3]); w.z = pk2(b[0], b[1]); w.w = pk2(b[2], b[3]);
                        __builtin_nontemporal_store(w, (v4u*)(rp + bj * 128)); } }
        }
    }
};

namespace att {
constexpr int D = 128, LDX = 2048;
constexpr float SCALE = 0.08838834764831845f;
constexpr float THR = 8.f;
constexpr int NW = 8, QBLK = 32, KVBLK = 64, QB = NW * QBLK;
constexpr int SHM_V = KVBLK * 256 * 2, SHM_K = KVBLK * D * 2;
constexpr int LDS_ATT = 2 * SHM_V + 2 * SHM_K + NW * 64 * 4;
typedef float f32x16 __attribute__((ext_vector_type(16)));
typedef unsigned u32x4 __attribute__((ext_vector_type(4)));
#define KSWZ(row, colB) ((row) * 256 + ((colB) ^ (((row) & 7) << 4)))
#define SBAR() __builtin_amdgcn_sched_barrier(0)
__device__ __forceinline__ int v_st(int k, int c) { const int kk = (k & ~0xC) | ((k & 4) << 1) | ((k & 8) >> 1); return ((kk >> 3) * 4 + (c >> 5)) * 512 + ((kk & 7) * 32 + (c & 31)) * 2; }
__device__ __forceinline__ int v_rd_base(int lane) { return ((lane & 3) << 3) | (((lane >> 2) & 3) << 6) | (((lane >> 4) & 1) << 5) | (((lane >> 5) & 1) << 8); }
constexpr int v_rd_off(int d0, int ks, int half) { return d0 * 512 + ks * 4096 + half * 2048; }
__device__ __forceinline__ int crow(int r, int hi) { return (r & 3) + 8 * (r >> 2) + 4 * hi; }
__device__ __forceinline__ unsigned cvtpk(float lo, float hi) { return pk2(lo, hi); }
__device__ __forceinline__ bf16x8 load8(const bf16* p) { return *reinterpret_cast<const bf16x8*>(p); }
__device__ __forceinline__ void mask_tile(f32x16& p0, f32x16& p1, int dq, unsigned W) {
    const float NEG = -__builtin_inff();
#pragma unroll
    for (int r = 0; r < 16; ++r) {
        const int c = (r & 3) + 8 * (r >> 2);
        if ((unsigned)(dq - c) >= W) p0[r] = NEG;
        if ((unsigned)(dq - c - 32) >= W) p1[r] = NEG;
    }
}
__device__ __forceinline__ void partialSM(f32x16& p0, f32x16& p1, float& m_reg, float& mn, float& alpha) {
    float pmax = p0[0]; for (int r = 1; r < 16; ++r) pmax = fmaxf(pmax, p0[r]); for (int r = 0; r < 16; ++r) pmax = fmaxf(pmax, p1[r]);
    { auto rr = __builtin_amdgcn_permlane32_swap(__float_as_uint(pmax), __float_as_uint(pmax), false, false);
      pmax = fmaxf(__uint_as_float(rr[0]), __uint_as_float(rr[1])); }
    constexpr float C2 = 1.4426950408889634f * SCALE;
    if (__builtin_expect(__all((pmax - m_reg) * SCALE <= THR), 1)) { mn = m_reg; alpha = 1.f; }
    else { mn = fmaxf(m_reg, pmax); alpha = __builtin_amdgcn_exp2f((m_reg - mn) * C2); m_reg = mn; }
    const float mnL = -mn * C2;
    for (int r = 0; r < 16; ++r) p0[r] = fmaf(p0[r], C2, mnL); for (int r = 0; r < 16; ++r) p1[r] = fmaf(p1[r], C2, mnL);
    for (int r = 0; r < 16; ++r) p0[r] = __builtin_amdgcn_exp2f(p0[r]);
}
__device__ __forceinline__ void finishSM(f32x16& p0, f32x16& p1, float alpha, float& l_reg, bf16x8& pa0, bf16x8& pa1, bf16x8& pa2, bf16x8& pa3) {
    for (int r = 0; r < 16; ++r) p1[r] = __builtin_amdgcn_exp2f(p1[r]);
    float ps = 0; for (int r = 0; r < 16; ++r) ps += p0[r]; for (int r = 0; r < 16; ++r) ps += p1[r];
    { auto rr = __builtin_amdgcn_permlane32_swap(__float_as_uint(ps), __float_as_uint(ps), false, false);
      ps = __uint_as_float(rr[0]) + __uint_as_float(rr[1]); }
    l_reg = l_reg * alpha + ps;
#define PK4(P, B_, OUT) do { unsigned a0 = cvtpk(P[B_+0], P[B_+1]), a1 = cvtpk(P[B_+2], P[B_+3]);                          \
        unsigned b0 = cvtpk(P[B_+4], P[B_+5]), b1 = cvtpk(P[B_+6], P[B_+7]);                                             \
        auto r0 = __builtin_amdgcn_permlane32_swap(a0, b0, false, false); auto r1 = __builtin_amdgcn_permlane32_swap(a1, b1, false, false); \
        u32x4 w = {r0[0], r1[0], r0[1], r1[1]}; OUT = *reinterpret_cast<bf16x8*>(&w); } while (0)
    PK4(p0, 0, pa0); PK4(p0, 8, pa1); PK4(p1, 0, pa2); PK4(p1, 8, pa3);
#undef PK4
}
template <int KB>
__device__ __forceinline__ void qkt(f32x16& p0, f32x16& p1, const char* K_lds, int r32, int hi, const bf16x8* qr) {
    p0 = f32x16{}; p1 = f32x16{};
    const char* kb[4];
#pragma unroll
    for (int dd = 0; dd < 4; ++dd) kb[dd] = K_lds + KB * SHM_K + KSWZ(r32, (dd * 16 + hi * 8) * 2);
#pragma unroll
    for (int d0 = 0; d0 < 8; ++d0) { const char* a = kb[d0 & 3] + (d0 >> 2) * 128;
        bf16x8 b0 = *reinterpret_cast<const bf16x8*>(a);
        bf16x8 b1 = *reinterpret_cast<const bf16x8*>(a + 32 * 256);
        p0 = __builtin_amdgcn_mfma_f32_32x32x16_bf16(b0, qr[d0], p0, 0, 0, 0);
        p1 = __builtin_amdgcn_mfma_f32_32x32x16_bf16(b1, qr[d0], p1, 0, 0, 0); }
}
template <int VB>
__device__ __forceinline__ void pv_tile(f32x16* o, int vb0, bf16x8 pa0, bf16x8 pa1, bf16x8 pa2, bf16x8 pa3) {
#define TRRD(dst, off) asm volatile("ds_read_b64_tr_b16 %0, %1 offset:%2" : "=&v"(dst) : "v"(vb0), "i"(off) : "memory")
#define PV_D0(d0) do { s16x4 l0, l1, l2, l3, h0, h1, h2, h3; constexpr int b_ = VB * SHM_V + (d0) * 512; \
        TRRD(l0, b_); TRRD(h0, b_ + 4096); TRRD(l1, b_ + 8192); TRRD(h1, b_ + 12288); TRRD(l2, b_ + 16384); TRRD(h2, b_ + 20480); TRRD(l3, b_ + 24576); TRRD(h3, b_ + 28672); \
        asm volatile("s_waitcnt lgkmcnt(0)" ::: "memory"); SBAR();   \
        o[d0] = __builtin_amdgcn_mfma_f32_32x32x16_bf16(pa0, (bf16x8){l0[0], l0[1], l0[2], l0[3], h0[0], h0[1], h0[2], h0[3]}, o[d0], 0, 0, 0);   \
        o[d0] = __builtin_amdgcn_mfma_f32_32x32x16_bf16(pa1, (bf16x8){l1[0], l1[1], l1[2], l1[3], h1[0], h1[1], h1[2], h1[3]}, o[d0], 0, 0, 0);   \
        o[d0] = __builtin_amdgcn_mfma_f32_32x32x16_bf16(pa2, (bf16x8){l2[0], l2[1], l2[2], l2[3], h2[0], h2[1], h2[2], h2[3]}, o[d0], 0, 0, 0);   \
        o[d0] = __builtin_amdgcn_mfma_f32_32x32x16_bf16(pa3, (bf16x8){l3[0], l3[1], l3[2], l3[3], h3[0], h3[1], h3[2], h3[3]}, o[d0], 0, 0, 0); } while (0)
    PV_D0(0); PV_D0(1); PV_D0(2); PV_D0(3); PV_D0(4); PV_D0(5); PV_D0(6); PV_D0(7);
#undef PV_D0
#undef TRRD
}
struct BlockRef { const bf16* Q; const bf16* K; const bf16* V; bf16* O; int P0; const bf16* O1r; bf16* H; float lam; int comb; };
#define VMW() asm volatile("s_waitcnt vmcnt(0)" ::: "memory")
__device__ __forceinline__ void causal_block(const BlockRef& cur, char* lds, const int wid) {
    const int W = 1 << 30;
    const int lane = fresh_lane(), tid = wid * 64 + lane, r32 = lane & 31, hi = lane >> 5;
    const int NT = cur.P0 / KVBLK + 4;
    const int qlo = cur.P0 + wid * QBLK, qm = qlo + r32 - 4 * hi;
    char* V_lds = lds; char* K_lds = lds + 2 * SHM_V;
    float* ws = (float*)(lds + 2 * SHM_V + 2 * SHM_K) + wid * 64; float* li_l = ws, * al_l = ws + 32;
    const int vb0 = (int)(uintptr_t)V_lds + v_rd_base(lane);
    unsigned ko[2], vo[4];
#pragma unroll
    for (int i = 0; i < 2; ++i) { const int b = 16 * (tid + 512 * i), row = b >> 8, colB = (b & 255) ^ ((row & 7) << 4); ko[i] = (unsigned)(row * LDX * 2 + colB); }
#pragma unroll
    for (int i = 0; i < 4; ++i) { const int b = 16 * (tid + 512 * i), idx = b >> 9, within = b & 511, kk = (idx >> 3) * 8 + (within >> 6), c = (idx & 7) * 32 + ((within & 63) >> 1);
        const int k = (kk & ~0xC) | ((kk & 4) << 1) | ((kk & 8) >> 1); vo[i] = (unsigned)((k * LDX + c) * 2); }
    typedef __attribute__((address_space(3))) unsigned lds_u32;
#define DMA_TILE(t, bf) do { const char* kg_ = (const char*)cur.K + (size_t)(t) * (KVBLK * LDX * 2); const char* vg_ = (const char*)cur.V + (size_t)(t) * (KVBLK * LDX * 2); \
        asm volatile("" : "+s"(kg_), "+s"(vg_)); asm volatile("" : "+v"(ko[0]), "+v"(ko[1]), "+v"(vo[0]), "+v"(vo[1]), "+v"(vo[2]), "+v"(vo[3]));        \
        _Pragma("unroll") for (int i_ = 0; i_ < 2; ++i_) __builtin_amdgcn_global_load_lds((const unsigned*)(kg_ + ko[i_]), (lds_u32*)(unsigned)(uintptr_t)(K_lds + (bf) * SHM_K + i_ * 8192 + wid * 1024), 16, 0, 0); \
        _Pragma("unroll") for (int i_ = 0; i_ < 4; ++i_) __builtin_amdgcn_global_load_lds((const unsigned*)(vg_ + vo[i_]), (lds_u32*)(unsigned)(uintptr_t)(V_lds + (bf) * SHM_V + i_ * 8192 + wid * 1024), 16, 0, 0); } while (0)
    bf16x8 qr[8];
#pragma unroll
    for (int d0 = 0; d0 < 8; ++d0) qr[d0] = load8(cur.Q + (size_t)(wid * QBLK + r32) * LDX + d0 * 16 + hi * 8);
    DMA_TILE(0, 0);
    float m_reg = -1e30f, l_reg = 0; f32x16 o[8] = {};
    VMW(); __syncthreads();
#define RESC(a) do { if (__any((a) < 1.f)) { if (hi == 0) al_l[r32] = (a); asm volatile("s_waitcnt lgkmcnt(0)" ::: "memory");              \
                     for (int d_ = 0; d_ < 8; ++d_) for (int r = 0; r < 16; ++r) o[d_][r] *= al_l[crow(r, hi)]; } } while (0)
#define MASKT(P0_, P1_, t) do { const int kb_ = (t) * KVBLK; if (kb_ + KVBLK - 1 > qlo) mask_tile(P0_, P1_, qm - kb_, (unsigned)W); } while (0)
#define STEP(t, BF) do { f32x16 p0, p1; float mn, al; bf16x8 pa0, pa1, pa2, pa3;                                   \
        if ((t) + 1 < NT) DMA_TILE((t) + 1, (BF) ^ 1);                                                              \
        if ((t) * KVBLK <= qlo + QBLK - 1) {         \
        SBAR(); qkt<BF>(p0, p1, K_lds, r32, hi, qr); SBAR();                                                        \
        MASKT(p0, p1, (t)); partialSM(p0, p1, m_reg, mn, al); RESC(al);                                             \
        finishSM(p0, p1, al, l_reg, pa0, pa1, pa2, pa3); SBAR();                                                    \
        pv_tile<BF>(o, vb0, pa0, pa1, pa2, pa3); }                                                                  \
        VMW(); __syncthreads(); } while (0)
    for (int t = 0; t < NT; t += 2) { STEP(t, 0); STEP(t + 1, 1); }
    if (hi == 0) li_l[r32] = l_reg; asm volatile("s_waitcnt lgkmcnt(0)" ::: "memory");
    if (!cur.comb) {
    float rli[16];
#pragma unroll
    for (int r = 0; r < 16; ++r) rli[r] = __builtin_amdgcn_rcpf(li_l[crow(r, hi)]);
    bf16* Ow = cur.O + (size_t)(wid * QBLK) * LDX;
#pragma unroll
    for (int r = 0; r < 16; ++r) { const int orow = crow(r, hi);
#pragma unroll
        for (int d0 = 0; d0 < 8; ++d0) { const float v = o[d0][r] * rli[r];
            const float vn = __builtin_bit_cast(float, __builtin_amdgcn_update_dpp(0, __builtin_bit_cast(int, v), 0xB1, 0xf, 0xf, true));
            if ((r32 & 1) == 0) *(unsigned*)(Ow + (size_t)orow * LDX + d0 * 32 + r32) = cvtpk(v, vn); } }
    } else {
    const int ln_ = fresh_lane(), r32 = ln_ & 31, hi = ln_ >> 5;
    const bool oddl = (r32 & 1) != 0; const float lam = cur.lam;
    const char* O1u = (const char*)(cur.O1r + (size_t)(wid * QBLK) * LDX); char* Hu = (char*)(cur.H + (size_t)(wid * QBLK) * LDX);
    const unsigned lo_ = (unsigned)((4 * hi * LDX + (r32 & ~1)) * 2), so_ = (unsigned)((4 * hi * LDX + r32) * 2);
#define RC_(r) ((size_t)((((r) & 3) + 8 * ((r) >> 2)) * LDX * 2))
    unsigned wn[4][8];
#pragma unroll
    for (int i = 0; i < 4; ++i)
#pragma unroll
        for (int d0 = 0; d0 < 8; ++d0) wn[i][d0] = *(const unsigned*)(O1u + RC_(i) + d0 * 64 + (size_t)lo_);
#pragma unroll
    for (int bt = 0; bt < 4; ++bt) { unsigned wc[4][8];
#pragma unroll
        for (int i = 0; i < 4; ++i)
#pragma unroll
            for (int d0 = 0; d0 < 8; ++d0) wc[i][d0] = wn[i][d0];
        if (bt < 3) {
#pragma unroll
            for (int i = 0; i < 4; ++i)
#pragma unroll
                for (int d0 = 0; d0 < 8; ++d0) wn[i][d0] = *(const unsigned*)(O1u + RC_(4 * bt + 4 + i) + d0 * 64 + (size_t)lo_); }
        asm volatile("" ::: "memory");
        float dv[4][8];
#pragma unroll
        for (int i = 0; i < 4; ++i) { const int r = 4 * bt + i; const float rl = __builtin_amdgcn_rcpf(li_l[crow(r, hi)]); float ss = 0.f;
#pragma unroll
            for (int d0 = 0; d0 < 8; ++d0) { const float dd = (oddl ? bfhi(wc[i][d0]) : bflo(wc[i][d0])) - lam * (o[d0][r] * rl); dv[i][d0] = dd; ss += dd * dd; }
            ss += __builtin_bit_cast(float, __builtin_amdgcn_update_dpp(0, __builtin_bit_cast(int, ss), 0xB1, 0xf, 0xf, true));
            ss += __builtin_bit_cast(float, __builtin_amdgcn_update_dpp(0, __builtin_bit_cast(int, ss), 0x4E, 0xf, 0xf, true));
            ss += __builtin_bit_cast(float, __builtin_amdgcn_update_dpp(0, __builtin_bit_cast(int, ss), 0x141, 0xf, 0xf, true));
            ss += __builtin_bit_cast(float, __builtin_amdgcn_update_dpp(0, __builtin_bit_cast(int, ss), 0x140, 0xf, 0xf, true));
            ss += __builtin_bit_cast(float, __builtin_amdgcn_ds_bpermute((ln_ ^ 16) << 2, __builtin_bit_cast(int, ss)));
            const float rs = rsqrtf(ss * (1.0f / 256.0f) + NORM_EPS);
#pragma unroll
            for (int d0 = 0; d0 < 8; ++d0) dv[i][d0] *= rs; }
#pragma unroll
        for (int i = 0; i < 4; ++i) {
#pragma unroll
            for (int d0 = 0; d0 < 8; ++d0) { const float v = dv[i][d0]; const float vn = __builtin_bit_cast(float, __builtin_amdgcn_update_dpp(0, __builtin_bit_cast(int, v), 0xB1, 0xf, 0xf, true));
                if (!oddl) *(unsigned*)(Hu + RC_(4 * bt + i) + d0 * 64 + (size_t)so_) = cvtpk(v, vn); } }
        asm volatile("" ::: "memory"); }
#undef RC_
    }
    __syncthreads();
#undef RESC
#undef MASKT
#undef STEP
#undef DMA_TILE
}
#undef VMW
#undef KSWZ
#undef SBAR
__device__ __forceinline__ BlockRef make_ref(int L, int pass, int comp, const bf16* Q, const bf16* K, const bf16* V, bf16* O1, bf16* H, float lam) {
    const int xcd = L & 7, k = L >> 3, g = (k >> 2) * 8 + xcd, x = k & 3;
    const int b = g >> 3, head = g & 7, qb = pass ? 7 - x : x;
    const size_t rowb = (size_t)b * SEQ * LDX, blk = rowb + (size_t)qb * QB * LDX + head * 256;
    BlockRef R;
    R.Q = Q + blk + comp * 128;
    R.K = K + rowb + head * 256 + comp * 128;
    R.V = V + rowb + head * 256;
    R.O = O1 + blk; R.O1r = O1 + blk; R.H = H + blk; R.lam = lam; R.comb = comp;
    R.P0 = qb * QB;
    return R;
}
__device__ __forceinline__ void attn_phase(char* lds, const bf16* Q, const bf16* K, const bf16* V, bf16* O1, bf16* H, float lam, int G, int bx, const int wid) {
    constexpr int total = 512;
    for (int L = bx; L < total; L += G)
#pragma unroll 1
        for (int pc = 0; pc < 4; ++pc) { const BlockRef cur = make_ref(L, pc >> 1, pc & 1, Q, K, V, O1, H, lam); causal_block(cur, lds, wid); }
}
}

struct Args { const float* in[20]; float* out; unsigned char* ws; int ph_lo, ph_hi; };
constexpr int NPHASE = 19;

#define CAS __attribute__((address_space(4)))
__device__ __forceinline__ const CAS unsigned char* karg_base() { const CAS unsigned char* ka = (const CAS unsigned char*)__builtin_amdgcn_kernarg_segment_ptr(); asm volatile("" : "+s"(ka)); return ka; }
__device__ __forceinline__ const float* arg_in(int k) { return *(const float* const CAS*)(karg_base() + 8 * k); }
__device__ __forceinline__ float* arg_out() { return *(float* const CAS*)(karg_base() + 160); }
__device__ __forceinline__ unsigned char* arg_ws() { return *(unsigned char* const CAS*)(karg_base() + 168); }
static_assert(sizeof(Args) == 184, "Args layout");

template <bool TILED> __device__ __forceinline__ void cvt_item(const float* W, int K, int N, bf16* WT, int kb, int nb, int drow0, const float* ks, int ksmask, float scal, LAS float* scr, int lane) {
    const int k0 = kb * 64, n0 = nb * 64, q = lane >> 4, c4 = (lane & 15) * 4;
    f32x4 v[16];
#pragma unroll
    for (int i = 0; i < 16; ++i) v[i] = *(const GAS f32x4*)(W + (size_t)(k0 + 4 * i + q) * N + n0 + c4);
    const int c = lane & 7;
    f32x4 s0 = {scal, scal, scal, scal}, s1 = s0;
    if (ks) { const int kk = (k0 + 8 * c) & ksmask; s0 = *(const f32x4*)(ks + kk) * scal; s1 = *(const f32x4*)(ks + kk + 4) * scal; }
#pragma unroll
    for (int i = 0; i < 16; ++i) { LAS float* d = scr + (4 * i + q) * 65 + c4; d[0] = v[i][0]; d[1] = v[i][1]; d[2] = v[i][2]; d[3] = v[i][3]; }
    LDS_WAIT(); asm volatile("" ::: "memory");
#pragma unroll
    for (int j = 0; j < 8; ++j) { const int n = (lane >> 3) + 8 * j; const LAS float* s = scr + (8 * c) * 65 + n;
        v4u o; o.x = pk2(s[0 * 65] * s0[0], s[1 * 65] * s0[1]); o.y = pk2(s[2 * 65] * s0[2], s[3 * 65] * s0[3]); o.z = pk2(s[4 * 65] * s1[0], s[5 * 65] * s1[1]); o.w = pk2(s[6 * 65] * s1[2], s[7 * 65] * s1[3]);
        const int dr = drow0 + n;
        bf16* dst = TILED ? WT + (size_t)(dr >> 8) * 256 * K + (size_t)kb * 16384 + (dr & 255) * 64 + 8 * c : WT + (size_t)dr * K + k0 + 8 * c;
        *(GAS v4u*)dst = o; }
    LDS_WAIT(); asm volatile("" ::: "memory");
}
__device__ __forceinline__ bool cvt_matrix(int& r, const float* W, int K, int N, bf16* WT, int mode, const float* ks, int ksmask, float scal, int scal_n, LAS float* scr, int lane) {
    const int nblk = N / 64, items = (K / 64) * nblk;
    if (r >= items) { r -= items; return false; }
    const int kb = r / nblk, nb = r % nblk, n0 = nb * 64; int d0 = n0;
    if (mode == 1) { const int isup = n0 >= DFF ? 1 : 0, j = n0 - isup * DFF; d0 = (j >> 7) * 256 + isup * 128 + (j & 127); }
    else if (mode == 2 && n0 < 2048) { const int head = n0 >> 8, comp = (n0 >> 7) & 1, half = (n0 >> 6) & 1; d0 = head * 256 + half * 128 + comp * 64; }
    if (mode == 3) cvt_item<true>(W, K, N, WT, kb, nb, d0, ks, ksmask, n0 < scal_n ? scal : 1.0f, scr, lane);
    else cvt_item<false>(W, K, N, WT, kb, nb, d0, ks, ksmask, n0 < scal_n ? scal : 1.0f, scr, lane);
    return true;
}

namespace hg {
constexpr int QS_OFF = 0, KS_OFF = 8704, KH_OFF = 17408, VS_OFF = 26112, AT_OFF = 34816, DEC_OFF = 36864, RED_OFF = 37376, BUF = 38400;
constexpr int QPITCH = 272;
struct Stage { f32x4 b0, b1, l0, l1, p0, p1; v4u q, v; };
__device__ __forceinline__ void prefetch(Stage& S, const float* Bc, const bf16* Qb, const bf16* Vb, size_t off, size_t off31, size_t offp) {
    S.b0 = *(const f32x4*)(Bc + off); S.b1 = *(const f32x4*)(Bc + off + 4); S.l0 = *(const f32x4*)(Bc + off31); S.l1 = *(const f32x4*)(Bc + off31 + 4);
    S.q = *(const v4u*)(Qb + off); S.p0 = *(const f32x4*)(Bc + offp); S.p1 = *(const f32x4*)(Bc + offp + 4); S.v = *(const v4u*)(Vb + off);
}
__device__ __forceinline__ void stage(const Stage& S, int t, int c, LAS unsigned char* B) {
    const float b[8] = {S.b0[0], S.b0[1], S.b0[2], S.b0[3], S.b1[0], S.b1[1], S.b1[2], S.b1[3]};
    const float bl[8] = {S.l0[0], S.l0[1], S.l0[2], S.l0[3], S.l1[0], S.l1[1], S.l1[2], S.l1[3]};
    const float qf[8] = {bflo(S.q.x), bfhi(S.q.x), bflo(S.q.y), bfhi(S.q.y), bflo(S.q.z), bfhi(S.q.z), bflo(S.q.w), bfhi(S.q.w)};
    const float pz = t > 0 ? 1.0f : 0.0f;
    const float bp[8] = {S.p0[0] * pz, S.p0[1] * pz, S.p0[2] * pz, S.p0[3] * pz, S.p1[0] * pz, S.p1[1] * pz, S.p1[2] * pz, S.p1[3] * pz};
    float kf[8];
#pragma unroll
    for (int j = 0; j < 8; ++j) kf[j] = 1.0f - __expf(b[j] - bp[j]);
    float qs[8], ks[8], kh[8], d[8];
#pragma unroll
    for (int j = 0; j < 8; ++j) { d[j] = __expf(bl[j]); qs[j] = qf[j] * __expf(b[j]); ks[j] = kf[j] * __expf(fminf(-b[j], 80.f)); kh[j] = kf[j] * __expf(bl[j] - b[j]); }
    v4u w;
    w.x = pk2(qs[0], qs[1]); w.y = pk2(qs[2], qs[3]); w.z = pk2(qs[4], qs[5]); w.w = pk2(qs[6], qs[7]); *(LAS v4u*)(B + QS_OFF + t * QPITCH + c * 16) = w;
    w.x = pk2(ks[0], ks[1]); w.y = pk2(ks[2], ks[3]); w.z = pk2(ks[4], ks[5]); w.w = pk2(ks[6], ks[7]); *(LAS v4u*)(B + KS_OFF + t * QPITCH + c * 16) = w;
    w.x = pk2(kh[0], kh[1]); w.y = pk2(kh[2], kh[3]); w.z = pk2(kh[4], kh[5]); w.w = pk2(kh[6], kh[7]); *(LAS v4u*)(B + KH_OFF + t * QPITCH + c * 16) = w;
    *(LAS v4u*)(B + VS_OFF + t * QPITCH + c * 16) = S.v;
    if (t == 31) { *(LAS f32x4*)(B + DEC_OFF + c * 32) = (f32x4){d[0], d[1], d[2], d[3]}; *(LAS f32x4*)(B + DEC_OFF + c * 32 + 16) = (f32x4){d[4], d[5], d[6], d[7]}; }
}
#define HG_TR(dst, addr, off) asm volatile("ds_read_b64_tr_b16 %0, %1 offset:%2" : "=&v"(dst) : "v"(addr), "i"(off) : "memory")
__device__ __forceinline__ void scan_phase(LAS unsigned char* lds, const bf16* Qin, bf16* OUT, const float* Bc, const bf16* Vb, const bf16* SGb, int G, int vcu, const int w) {
    const int lane = fresh_lane(), tid = w * 64 + lane, l15 = lane & 15, q4 = lane >> 4;
    const int st = tid >> 4, sc = tid & 15;
    for (int unit = vcu; unit < 256; unit += G) {
        const int b = unit >> 4, h = unit & 15;
        const size_t base = (size_t)b * SEQ * DM + h * 128;
        __syncthreads();
        if (tid < 128) { const int bufi = tid >> 6, r = (tid >> 2) & 15, part = tid & 3; *(LAS u64*)(lds + bufi * BUF + AT_OFF + r * 64 + 32 + part * 8) = 0ull; }
        f32x4 S[8];
#pragma unroll
        for (int j = 0; j < 8; ++j) S[j] = (f32x4){0.f, 0.f, 0.f, 0.f};
        Stage P;
        prefetch(P, Bc, Qin, Vb, base + (size_t)st * DM + sc * 8, base + (size_t)31 * DM + sc * 8, base + (size_t)(st > 0 ? st - 1 : 0) * DM + sc * 8);
        stage(P, st, sc, lds);
        LDS_WAIT(); __syncthreads();
        for (int c = 0; c < 64; ++c) {
            LAS unsigned char* B = lds + (c & 1) * BUF;
            const size_t crow0 = base + (size_t)c * 32 * DM;
            if (c + 1 < 64) prefetch(P, Bc, Qin, Vb, crow0 + (size_t)(32 + st) * DM + sc * 8, crow0 + (size_t)63 * DM + sc * 8, crow0 + (size_t)(32 + (st > 0 ? st - 1 : 0)) * DM + sc * 8);
            const v2u sg0 = *(const v2u*)(SGb + crow0 + (size_t)l15 * DM + 16 * w + 4 * q4);
            const v2u sg1 = *(const v2u*)(SGb + crow0 + (size_t)(l15 + 16) * DM + 16 * w + 4 * q4);
            if (w < 3) { const int tt = w > 0 ? 1 : 0, stl = w > 1 ? 1 : 0; f32x4 a = {0.f, 0.f, 0.f, 0.f};
#pragma unroll
                for (int j = 0; j < 4; ++j) { const bf16x8 qa = *(const LAS bf16x8*)(B + QS_OFF + (16 * tt + l15) * QPITCH + (32 * j + 8 * q4) * 2);
                    const bf16x8 kb = *(const LAS bf16x8*)(B + KS_OFF + (16 * stl + l15) * QPITCH + (32 * j + 8 * q4) * 2);
                    a = __builtin_amdgcn_mfma_f32_16x16x32_bf16(qa, kb, a, 0, 0, 0); }
#pragma unroll
                for (int i = 0; i < 4; ++i) { const int t = 16 * tt + 4 * q4 + i, s_ = 16 * stl + l15; const float v = s_ <= t ? a[i] : 0.f;
                    *(LAS unsigned short*)(B + AT_OFF + t * 64 + s_ * 2) = (unsigned short)pk2(v, 0.f); } }
            f32x4 o0 = {0.f, 0.f, 0.f, 0.f}, o1 = {0.f, 0.f, 0.f, 0.f};
#pragma unroll
            for (int j = 0; j < 4; ++j) { v4u sw; sw.x = pk2(S[2 * j][0], S[2 * j][1]); sw.y = pk2(S[2 * j][2], S[2 * j][3]); sw.z = pk2(S[2 * j + 1][0], S[2 * j + 1][1]); sw.w = pk2(S[2 * j + 1][2], S[2 * j + 1][3]);
                const bf16x8 sa = __builtin_bit_cast(bf16x8, sw);
                const LAS unsigned char* qp = B + QS_OFF + l15 * QPITCH + (32 * j + 4 * q4) * 2;
                const v2u a0 = *(const LAS v2u*)qp, a1 = *(const LAS v2u*)(qp + 32), c0 = *(const LAS v2u*)(qp + 16 * QPITCH), c1 = *(const LAS v2u*)(qp + 16 * QPITCH + 32);
                const v4u f0 = {a0.x, a0.y, a1.x, a1.y}, f1 = {c0.x, c0.y, c1.x, c1.y};
                o0 = __builtin_amdgcn_mfma_f32_16x16x32_bf16(sa, __builtin_bit_cast(bf16x8, f0), o0, 0, 0, 0);
                o1 = __builtin_amdgcn_mfma_f32_16x16x32_bf16(sa, __builtin_bit_cast(bf16x8, f1), o1, 0, 0, 0); }
            const unsigned trb = (unsigned)(uintptr_t)B + (8 * q4 + (l15 >> 2)) * QPITCH + (l15 & 3) * 8;
            s16x4 vlo, vhi;
            HG_TR(vlo, trb + VS_OFF + 32 * w, 0); HG_TR(vhi, trb + VS_OFF + 32 * w, 4 * QPITCH);
            LDS_WAIT(); __syncthreads(); __builtin_amdgcn_sched_barrier(0);
            const bf16x8 vt = (bf16x8){vlo[0], vlo[1], vlo[2], vlo[3], vhi[0], vhi[1], vhi[2], vhi[3]};
            { const bf16x8 at0 = *(const LAS bf16x8*)(B + AT_OFF + l15 * 64 + q4 * 16), at1 = *(const LAS bf16x8*)(B + AT_OFF + (l15 + 16) * 64 + q4 * 16);
              o0 = __builtin_amdgcn_mfma_f32_16x16x32_bf16(vt, at0, o0, 0, 0, 0);
              o1 = __builtin_amdgcn_mfma_f32_16x16x32_bf16(vt, at1, o1, 0, 0, 0); }
            { float p0 = (o0[0] * o0[0] + o0[1] * o0[1]) + (o0[2] * o0[2] + o0[3] * o0[3]), p1 = (o1[0] * o1[0] + o1[1] * o1[1]) + (o1[2] * o1[2] + o1[3] * o1[3]);
              p0 += __shfl_xor(p0, 16); p0 += __shfl_xor(p0, 32); p1 += __shfl_xor(p1, 16); p1 += __shfl_xor(p1, 32);
              if (q4 == 0) { *(LAS float*)(B + RED_OFF + (w * 32 + l15) * 4) = p0; *(LAS float*)(B + RED_OFF + (w * 32 + 16 + l15) * 4) = p1; } }
#pragma unroll
            for (int jp = 0; jp < 4; ++jp) { s16x4 a0, a1, c0, c1;
                HG_TR(a0, trb + KH_OFF, (2 * jp) * 32); HG_TR(a1, trb + KH_OFF, (2 * jp) * 32 + 4 * QPITCH); HG_TR(c0, trb + KH_OFF, (2 * jp + 1) * 32); HG_TR(c1, trb + KH_OFF, (2 * jp + 1) * 32 + 4 * QPITCH);
                const f32x4 d0 = *(const LAS f32x4*)(B + DEC_OFF + (16 * (2 * jp) + 4 * q4) * 4), d1 = *(const LAS f32x4*)(B + DEC_OFF + (16 * (2 * jp + 1) + 4 * q4) * 4);
                LDS_WAIT(); __builtin_amdgcn_sched_barrier(0);
                S[2 * jp] = __builtin_amdgcn_mfma_f32_16x16x32_bf16((bf16x8){a0[0], a0[1], a0[2], a0[3], a1[0], a1[1], a1[2], a1[3]}, vt, S[2 * jp] * d0, 0, 0, 0);
                S[2 * jp + 1] = __builtin_amdgcn_mfma_f32_16x16x32_bf16((bf16x8){c0[0], c0[1], c0[2], c0[3], c1[0], c1[1], c1[2], c1[3]}, vt, S[2 * jp + 1] * d1, 0, 0, 0); }
            if (c + 1 < 64) stage(P, st, sc, lds + ((c + 1) & 1) * BUF);
            LDS_WAIT(); __syncthreads();
            float s0 = 0.f, s1 = 0.f;
#pragma unroll
            for (int ww = 0; ww < 8; ++ww) { s0 += *(const LAS float*)(B + RED_OFF + (ww * 32 + l15) * 4); s1 += *(const LAS float*)(B + RED_OFF + (ww * 32 + 16 + l15) * 4); }
            const float r0 = rsqrtf(s0 * (1.0f / 128.0f) + NORM_EPS), r1 = rsqrtf(s1 * (1.0f / 128.0f) + NORM_EPS);
            v2u w0, w1;
            w0.x = pk2(o0[0] * r0 * bflo(sg0.x), o0[1] * r0 * bfhi(sg0.x)); w0.y = pk2(o0[2] * r0 * bflo(sg0.y), o0[3] * r0 * bfhi(sg0.y));
            w1.x = pk2(o1[0] * r1 * bflo(sg1.x), o1[1] * r1 * bfhi(sg1.x)); w1.y = pk2(o1[2] * r1 * bflo(sg1.y), o1[3] * r1 * bfhi(sg1.y));
            *(v2u*)(OUT + crow0 + (size_t)l15 * DM + 16 * w + 4 * q4) = w0;
            *(v2u*)(OUT + crow0 + (size_t)(l15 + 16) * DM + 16 * w + 4 * q4) = w1;
        }
    }
}
#undef HG_TR
}

__global__ void __launch_bounds__(NWAVES * 64, 2) yoco_fwd(Args args) {
    extern __shared__ __attribute__((aligned(16))) unsigned char lds_raw[];
    LAS unsigned char* lds = (LAS unsigned char*)lds_raw;
    volatile LAS unsigned* MISC = (volatile LAS unsigned*)(lds + MISC_OFF);
    const int wave = __builtin_amdgcn_readfirstlane((int)threadIdx.x >> 6);
    const int G = gridDim.x, bx = blockIdx.x, vcu = (G % 8 == 0) ? (bx % 8) * (G / 8) + bx / 8 : bx;
    for (int u = wave * 64 + fresh_lane(); u < (LDS_BYTES - LDSCTL_OFF) / 4; u += NWAVES * 64) ((LAS unsigned*)(lds + LDSCTL_OFF))[u] = 0u;
    __syncthreads();
    XcdBarrier bar; bar.bar = (unsigned*)(arg_ws() + WS_CTL) + CW_BAR; bar.x = 0; bar.st = nullptr;
    if (MK_N_LAUNCHES == 1) bar = xcd_barrier_post((unsigned*)(arg_ws() + WS_CTL) + CW_BAR, MISC + 8, wave);
#define GRID_BAR() do { if (MK_N_LAUNCHES == 1) xcd_barrier(bar, wave); } while (0)
    const int lo = args.ph_lo, hi = args.ph_hi;
#define IN(k) (lo <= (k) && (k) < hi)
#define BOTH(k) (IN(k) && IN((k) + 1))
#define STAT(i) ((float*)(ws + WS_STATS) + (size_t)(i) * 8 * MTOK)
#define REDP ((LAS float*)(lds + RED_OFF))
#define WPTR(off) ((bf16*)(ws + WS_W + (off)))
#define BIGP(T, off) ((T*)(ws + WS_BIG + (off)))
#define HB1P ((bf16*)(ws + WS_HB1))
#define HB2P ((bf16*)(ws + WS_HB2))
#define ROPE_COS ((float*)(ws + WS_TAB))
#define ROPE_SIN ((float*)(ws + WS_TAB + 512 * 1024))
#define LBTAB ((float*)(ws + WS_TAB + MiB))
#define LAMP ((float*)(ws + WS_TAB + MiB + 16384))
#define FNTAB ((float*)(ws + WS_TAB + MiB + 32768))

    if (IN(0)) {
        for (int rep_ = 0; rep_ < (PROBE_DUP == 0 ? 2 : 1); ++rep_) {
        unsigned char* ws = arg_ws();
        const int lane = fresh_lane(), tid = wave * 64 + lane;
        LAS float* scr = (LAS float*)(lds + RING_OFF + wave * 16640);
        const int gw = vcu * NWAVES + wave, NGW = G * NWAVES;
        constexpr int ITEMS = (4 * DM * NGU + 4 * DFF * DM + DM * 8192 + 5 * DM * DM + DM * 4096 + 2 * 256 * DM) / 4096;
        for (int it = gw; it < ITEMS; it += NGW) {
            int r = it; bool done = false;
#pragma unroll 1
            for (int f = 0; f < 4 && !done; ++f) done = cvt_matrix(r, arg_in(3) + (size_t)f * DM * NGU, DM, NGU, WPTR(W_GU + (size_t)f * 44 * MiB), 1, arg_in(2) + f * DM, DM - 1, 1.0f, 0, scr, lane);
#pragma unroll 1
            for (int f = 0; f < 4 && !done; ++f) done = cvt_matrix(r, arg_in(4) + (size_t)f * DFF * DM, DFF, DM, WPTR(W_DN + (size_t)f * 22 * MiB), 3, nullptr, 0, 1.0f, 0, scr, lane);
            if (!done) done = cvt_matrix(r, arg_in(6), DM, 8192, WPTR(W_HIN), 0, arg_in(5), DM - 1, QSCALE, 2048, scr, lane);
            if (!done) done = cvt_matrix(r, arg_in(9), DM, DM, WPTR(W_HOUT), 0, arg_in(8), 127, 1.0f, 0, scr, lane);
            if (!done) done = cvt_matrix(r, arg_in(11), DM, 4096, WPTR(W_KV), 2, arg_in(10), DM - 1, 1.0f, 0, scr, lane);
            if (!done) done = cvt_matrix(r, arg_in(12), DM, DM, WPTR(W_Q), 2, arg_in(5) + DM, DM - 1, 1.0f, 0, scr, lane);
            if (!done) done = cvt_matrix(r, arg_in(15), DM, DM, WPTR(W_AO), 0, arg_in(14), 255, 1.0f - LAMBDA_INIT, DM, scr, lane);
#pragma unroll 1
            for (int f = 0; f < 2 && !done; ++f) done = cvt_matrix(r, arg_in(17) + (size_t)f * DM * DM, DM, DM, WPTR(W_PG + (size_t)f * 8 * MiB), 0, arg_in(16) + f * DM, DM - 1, 1.0f, 0, scr, lane);
#pragma unroll 1
            for (int f = 0; f < 2 && !done; ++f) done = cvt_matrix(r, arg_in(18) + (size_t)f * 256 * DM, 256, DM, WPTR(W_PP + (size_t)f * MiB), 0, nullptr, 0, 1.0f, 0, scr, lane);
        }
        { const float* x = arg_in(0); bf16* HB1 = HB1P; float* st0 = STAT(0);
          for (int m = gw; m < MTOK; m += NGW) {
            const GAS f32x4* xr = (const GAS f32x4*)(x + (size_t)m * DM) + lane; GAS v2u* o8 = (GAS v2u*)(HB1 + (size_t)m * DM) + lane; float s = 0.f;
#pragma unroll
            for (int j = 0; j < 8; ++j) { const f32x4 v = xr[64 * j]; s += (v[0] * v[0] + v[1] * v[1]) + (v[2] * v[2] + v[3] * v[3]); v2u o; o.x = pk2(v[0], v[1]); o.y = pk2(v[2], v[3]); o8[64 * j] = o; }
            s = wave_sum(s);
            if (lane < 8) st0[(size_t)lane * MTOK + m] = lane == 0 ? s : 0.f;
          } }
        { const float* pin = arg_in(1); bf16* PB = (bf16*)(ws + WS_PB); const size_t n8 = (size_t)2 * MTOK * 256 / 8;
          for (size_t i = (size_t)bx * 512 + tid; i < n8; i += (size_t)G * 512) { const f32x4 a = *(const f32x4*)(pin + i * 8), b = *(const f32x4*)(pin + i * 8 + 4);
              v4u o; o.x = pk2(a[0], a[1]); o.y = pk2(a[2], a[3]); o.z = pk2(b[0], b[1]); o.w = pk2(b[2], b[3]); *(v4u*)(PB + i * 8) = o; } }
        { float* rope_cos = ROPE_COS; float* rope_sin = ROPE_SIN;
          for (int e = bx * 512 + tid; e < SEQ * 64; e += G * 512) {
            const int pos = e >> 6, i = e & 63;
            double f = 1.0; for (int k = 0; k < i; ++k) f *= 0.8659643233600653;
            const float ang = (float)pos * (float)f;
            const double a = (double)ang; const double kq = __builtin_rint(a * 0.63661977236758134); const double rr = (a - kq * 1.5707963267948966) - kq * 6.123233995736766e-17;
            const double r2 = rr * rr;
            double sp = 1.0 / 6227020800.0; sp = sp * r2 - 1.0 / 39916800.0; sp = sp * r2 + 1.0 / 362880.0; sp = sp * r2 - 1.0 / 5040.0; sp = sp * r2 + 1.0 / 120.0; sp = sp * r2 - 1.0 / 6.0; sp = sp * r2 + 1.0; sp *= rr;
            double cp = 1.0 / 87178291200.0; cp = -cp * r2 + 1.0 / 479001600.0; cp = cp * r2 - 1.0 / 3628800.0; cp = cp * r2 + 1.0 / 40320.0; cp = cp * r2 - 1.0 / 720.0; cp = cp * r2 + 1.0 / 24.0; cp = cp * r2 - 0.5; cp = cp * r2 + 1.0;
            const int qd = ((int)kq) & 3;
            const double sv = qd == 0 ? sp : (qd == 1 ? cp : (qd == 2 ? -sp : -cp)), cv = qd == 0 ? cp : (qd == 1 ? -sp : (qd == 2 ? -cp : sp));
            rope_cos[e] = (float)cv; rope_sin[e] = (float)sv;
          } }
        { const float* lbin = arg_in(7); const float* fn = arg_in(19); float* lbtab = LBTAB; float* fnt = FNTAB;
          for (int e = bx * 512 + tid; e < DM; e += G * 512) { const float a0 = lbin[e], a1 = lbin[DM + e]; lbtab[e] = 1.0f / (1.0f + expf(a1 - a0)); fnt[e] = fn[e]; } }
        if (bx == 0 && wave == 0) { const float* lam = arg_in(13); float d1 = lam[lane] * lam[128 + lane] + lam[64 + lane] * lam[192 + lane], d2 = lam[256 + lane] * lam[384 + lane] + lam[320 + lane] * lam[448 + lane];
            d1 = wave_sum(d1); d2 = wave_sum(d2); if (lane == 0) LAMP[0] = expf(d1) - expf(d2) + LAMBDA_INIT; }
        }
        if (BOTH(0)) GRID_BAR();
    }

#define RSTAB ((const LAS float*)(lds + RSTAB_OFF))
#define FILL_RSTD(i) fill_rstd_table((LAS float*)(lds + RSTAB_OFF), STAT(i), bx, wave)
#define GEMM_PHASE_F(EpiT, Eobj, Aptr, Bptr, Nn, Kk, si) do { pg8::Gemm g_{(const bf16*)(Aptr), (const bf16*)(Bptr), MTOK, (Nn), (Kk)}; pg8::StaticOrder S_; S_.init(MTOK, (Nn), G, bx); \
        FillPre fp_{(LAS float*)(lds + RSTAB_OFF), STAT(si), bx, wave}; \
        pg8::gemm_phase<EpiT, pg8::StaticOrder, true, true, false, false, FillPre>(lds + RING_OFF, g_, S_, Eobj, wave, fp_); } while (0)
#define GEMM_PHASE_T(EpiT, Eobj, Aptr, Bptr, Nn, Kk) do { pg8::Gemm g_{(const bf16*)(Aptr), (const bf16*)(Bptr), MTOK, (Nn), (Kk)}; pg8::StaticOrder S_; S_.init(MTOK, (Nn), G, bx); \
        pg8::gemm_phase<EpiT, pg8::StaticOrder, true, true, true, true>(lds + RING_OFF, g_, S_, Eobj, wave); } while (0)
#define GEMM_PHASE(EpiT, Eobj, Aptr, Bptr, Nn, Kk) do { pg8::Gemm g_{(const bf16*)(Aptr), (const bf16*)(Bptr), MTOK, (Nn), (Kk)}; pg8::StaticOrder S_; S_.init(MTOK, (Nn), G, bx); \
        pg8::gemm_phase<EpiT, pg8::StaticOrder, true, true>(lds + RING_OFF, g_, S_, Eobj, wave); } while (0)

    if (IN(1)) { unsigned char* ws = arg_ws(); EpiGU E{BIGP(bf16, BIG_HID), RSTAB}; GEMM_PHASE_F(EpiGU, E, HB1P, WPTR(W_GU + 0 * 44 * MiB), NGU, DM, 0); if (PROBE_DUP == 100) { for (int rep_ = 0; rep_ < 20; ++rep_) GRID_BAR(); } if (BOTH(1)) GRID_BAR(); }
    if (IN(2)) { unsigned char* ws = arg_ws(); EpiRes<true> E{arg_in(0), HB1P, STAT(1), 0.5f, REDP}; GEMM_PHASE_T(EpiRes<true>, E, BIGP(bf16, BIG_HID), WPTR(W_DN + 0 * 22 * MiB), DM, DFF);
        if (BOTH(2)) GRID_BAR(); }
    if (IN(3)) { unsigned char* ws = arg_ws(); EpiHgIn E{BIGP(bf16, BIG_HQ), BIGP(float, BIG_HLF), BIGP(bf16, BIG_HV), BIGP(bf16, BIG_HSG), RSTAB, LBTAB};
        GEMM_PHASE_F(EpiHgIn, E, HB1P, WPTR(W_HIN), 8192, DM, 1); if (BOTH(3)) GRID_BAR(); }
    if (IN(4)) { unsigned char* ws = arg_ws();
        hg::scan_phase(lds + RING_OFF, BIGP(const bf16, BIG_HQ), BIGP(bf16, BIG_HQ), BIGP(const float, BIG_HLF), BIGP(const bf16, BIG_HV), BIGP(const bf16, BIG_HSG), G, vcu, wave); if (BOTH(4)) GRID_BAR(); }
    if (IN(5)) { unsigned char* ws = arg_ws(); EpiRes<false> E{HB1P, HB1P, STAT(2), 1.0f, REDP}; GEMM_PHASE(EpiRes<false>, E, BIGP(bf16, BIG_HQ), WPTR(W_HOUT), DM, DM); if (BOTH(5)) GRID_BAR(); }
    if (IN(6)) { unsigned char* ws = arg_ws(); EpiGU E{BIGP(bf16, BIG_HID), RSTAB}; GEMM_PHASE_F(EpiGU, E, HB1P, WPTR(W_GU + 1 * 44 * MiB), NGU, DM, 2); if (BOTH(6)) GRID_BAR(); }
    if (IN(7)) { unsigned char* ws = arg_ws();
                 { EpiRes<false> E{HB1P, HB1P, STAT(3), 0.5f, REDP}; GEMM_PHASE_T(EpiRes<false>, E, BIGP(bf16, BIG_HID), WPTR(W_DN + 1 * 22 * MiB), DM, DFF); }
                 { EpiPlain E{BIGP(bf16, BIG_PP)}; GEMM_PHASE(EpiPlain, E, ws + WS_PB, WPTR(W_PP), DM, 256); }
                 if (BOTH(7)) GRID_BAR(); }
    if (IN(8)) { unsigned char* ws = arg_ws(); EpiPleG E{HB1P, HB2P, STAT(4), RSTAB, BIGP(const bf16, BIG_PP), REDP}; GEMM_PHASE_F(EpiPleG, E, HB1P, WPTR(W_PG), DM, DM, 3); if (BOTH(8)) GRID_BAR(); }
    if (IN(9)) { unsigned char* ws = arg_ws();
                 { EpiRope E{BIGP(bf16, BIG_KR), BIGP(bf16, BIG_VV), 8, RSTAB, ROPE_COS, ROPE_SIN}; GEMM_PHASE_F(EpiRope, E, HB2P, WPTR(W_KV), 4096, DM, 4); }
                 { EpiGU E{BIGP(bf16, BIG_HID), RSTAB}; GEMM_PHASE(EpiGU, E, HB2P, WPTR(W_GU + 2 * 44 * MiB), NGU, DM); }
                 if (BOTH(9)) GRID_BAR(); }
    if (IN(10)) { unsigned char* ws = arg_ws(); EpiRes<false> E{HB2P, HB1P, STAT(5), 0.5f, REDP}; GEMM_PHASE_T(EpiRes<false>, E, BIGP(bf16, BIG_HID), WPTR(W_DN + 2 * 22 * MiB), DM, DFF); if (BOTH(10)) GRID_BAR(); }
    if (IN(11)) { unsigned char* ws = arg_ws(); EpiRope E{BIGP(bf16, BIG_QR), BIGP(bf16, BIG_QR), 8, RSTAB, ROPE_COS, ROPE_SIN}; GEMM_PHASE_F(EpiRope, E, HB1P, WPTR(W_Q), DM, DM, 5); if (BOTH(11)) GRID_BAR(); }
    if (IN(12)) { unsigned char* ws = arg_ws();
                  att::attn_phase((char*)lds_raw + RING_OFF, BIGP(const bf16, BIG_QR), BIGP(const bf16, BIG_KR), BIGP(const bf16, BIG_VV), BIGP(bf16, BIG_O1), HB2P, LAMP[0], G, bx, wave);
                  if (BOTH(12)) GRID_BAR(); }
    if (IN(13)) { }
    if (IN(14)) { unsigned char* ws = arg_ws(); EpiRes<false> E{HB1P, HB1P, STAT(6), 1.0f, REDP}; GEMM_PHASE(EpiRes<false>, E, HB2P, WPTR(W_AO), DM, DM); if (BOTH(14)) GRID_BAR(); }
    if (IN(15)) { unsigned char* ws = arg_ws(); EpiGU E{BIGP(bf16, BIG_HID), RSTAB}; GEMM_PHASE_F(EpiGU, E, HB1P, WPTR(W_GU + 3 * 44 * MiB), NGU, DM, 6); if (BOTH(15)) GRID_BAR(); }
    if (IN(16)) { unsigned char* ws = arg_ws();
                  { EpiRes<false> E{HB1P, HB1P, STAT(7), 0.5f, REDP}; GEMM_PHASE_T(EpiRes<false>, E, BIGP(bf16, BIG_HID), WPTR(W_DN + 3 * 22 * MiB), DM, DFF); }
                  { EpiPlain E{BIGP(bf16, BIG_PP)}; GEMM_PHASE(EpiPlain, E, ws + WS_PB + (size_t)MTOK * 256 * 2, WPTR(W_PP + MiB), DM, 256); }
                  if (BOTH(16)) GRID_BAR(); }
    if (IN(17)) { unsigned char* ws = arg_ws(); EpiPleG E{HB1P, HB2P, STAT(8), RSTAB, BIGP(const bf16, BIG_PP), REDP}; GEMM_PHASE_F(EpiPleG, E, HB1P, WPTR(W_PG + 8 * MiB), DM, DM, 7); if (BOTH(17)) GRID_BAR(); }
    if (IN(18)) {
        unsigned char* ws = arg_ws(); float* out = arg_out(); const bf16* HB2 = HB2P;
        const int lane = fresh_lane();
        const float* gn = FNTAB; const int gw = vcu * NWAVES + wave, NGW = G * NWAVES;
        unsigned poison = 0;
        if (MK_N_LAUNCHES == 1) poison = __hip_atomic_load((unsigned*)(ws + WS_CTL) + CW_BAR + XB_TMO, RLX_AGENT);
        const float* st8 = STAT(8);
        for (int m = gw; m < MTOK; m += NGW) { const float rs = poison ? __builtin_nanf("") : stat_rstd(st8, m);
#pragma unroll
            for (int j = 0; j < 4; ++j) { const int c = lane * 8 + 512 * j; const v4u r = *(const v4u*)(HB2 + (size_t)m * DM + c);
                const f32x4 g0 = *(const f32x4*)(gn + c), g1 = *(const f32x4*)(gn + c + 4);
                const f32x4 o0 = {bflo(r.x) * rs * g0[0], bfhi(r.x) * rs * g0[1], bflo(r.y) * rs * g0[2], bfhi(r.y) * rs * g0[3]};
                const f32x4 o1 = {bflo(r.z) * rs * g1[0], bfhi(r.z) * rs * g1[1], bflo(r.w) * rs * g1[2], bfhi(r.w) * rs * g1[3]};
                *(f32x4*)(out + (size_t)m * DM + c) = o0; *(f32x4*)(out + (size_t)m * DM + c + 4) = o1; } }
    }
#undef IN
#undef BOTH
}

extern "C" void kernel_launch(void* const* d_in, const int* in_sizes, int n_in, void* d_out, int out_size, void* d_ws, size_t ws_size, hipStream_t stream) {
    static int grid = 0;
    if (grid == 0) {
        if (n_in != 20 || in_sizes[0] != MTOK * DM || out_size != MTOK * DM || ws_size < WS_END) { fprintf(stderr, "kernel_launch: unexpected shapes (n_in %d, in0 %d, out %d, ws %zu < %zu)\n", n_in, n_in > 0 ? in_sizes[0] : -1, out_size, ws_size, (size_t)WS_END); grid = -1; return; }
        int dev = 0, cus = 0, per_cu = 0;
        if (hipGetDevice(&dev) != hipSuccess || hipDeviceGetAttribute(&cus, hipDeviceAttributeMultiprocessorCount, dev) != hipSuccess) { grid = -1; return; }
        if (hipFuncSetAttribute((const void*)yoco_fwd, hipFuncAttributeMaxDynamicSharedMemorySize, LDS_BYTES) != hipSuccess) { fprintf(stderr, "kernel_launch: hipFuncSetAttribute failed\n"); grid = -1; return; }
        if (hipOccupancyMaxActiveBlocksPerMultiprocessor(&per_cu, (const void*)yoco_fwd, NWAVES * 64, LDS_BYTES) != hipSuccess || per_cu < 1) fprintf(stderr, "kernel_launch: occupancy query says %d\n", per_cu);
        (void)hipGetLastError();
        grid = cus > 256 ? 256 : (cus / 8) * 8;
        if (grid < 8) { fprintf(stderr, "kernel_launch: device has %d CUs; at least 8 are needed\n", cus); grid = -1; return; }
    }
    if (grid < 0) return;
    (void)hipMemsetAsync((char*)d_ws + WS_CTL, 0, CTL_ZERO_BYTES, stream);
    Args a{};
    for (int i = 0; i < 20; ++i) a.in[i] = (const float*)d_in[i];
    a.out = (float*)d_out; a.ws = (unsigned char*)d_ws;
#if MK_N_LAUNCHES == 1
    a.ph_lo = 0; a.ph_hi = NPHASE;
    hipLaunchKernelGGL(yoco_fwd, dim3(grid), dim3(NWAVES * 64), LDS_BYTES, stream, a);
#else
    for (int k = 0; k < NPHASE; ++k) { a.ph_lo = k; a.ph_hi = k + 1; hipLaunchKernelGGL(yoco_fwd, dim3(grid), dim3(NWAVES * 64), LDS_BYTES, stream, a); }
#endif
}
```

```cpp
#include <hip/hip_runtime.h>
#include <hip/hip_bf16.h>
#include <cstdio>
#include <cstdint>

#ifndef PROBE_DUP
#define PROBE_DUP -1
#endif
#ifndef MK_N_LAUNCHES
#define MK_N_LAUNCHES 1
#endif

__device__ __forceinline__ int fresh_lane() { int l; asm volatile("v_mbcnt_lo_u32_b32 %0, -1, 0\n\tv_mbcnt_hi_u32_b32 %0, -1, %0" : "=v"(l)); return l; }
namespace pg8 {
#define PG8_LAS __attribute__((address_space(3)))
typedef unsigned short bf16_t;
typedef short bf16x8 __attribute__((ext_vector_type(8)));
typedef float f32x4 __attribute__((ext_vector_type(4)));
typedef unsigned u32x4 __attribute__((ext_vector_type(4)));
constexpr int BM = 256, BK = 64, HALF = 128, HTB = HALF * BK * 2, STAGE_BYTES = 8 * HTB, NXCD = 8, WGM = 4;

__host__ __device__ __forceinline__ int lds_byte(int r, int c) { const int st = (r >> 4) * 2 + (c >> 5), rr = r & 15, cc = c & 31, ob = rr * 64 + cc * 2; return st * 1024 + (ob ^ (((ob >> 9) & 1) << 5)); }
__host__ __device__ __forceinline__ void stage_rc(int b, int& R, int& C) { const int st = b / 1024, sb = b % 1024, swz = sb ^ (((sb >> 9) & 1) << 5); R = (st >> 1) * 16 + swz / 64; C = (st & 1) * 32 + (swz % 64) / 2; }
__host__ __device__ __forceinline__ int perm32(int rho) { const int n = rho >> 4, i = rho & 15; return 8 * (i >> 2) + 4 * n + (i & 3); }

struct Unit { int pm, pn; };
struct Gemm { const bf16_t* A; const bf16_t* Bt; int M, N, K; };

struct StaticOrder {
    int nM, nN, nwg, G, c;
    __host__ __device__ void init(int M, int N, int G_, int c_) { nM = M / BM; nN = N / BM; nwg = nM * nN; G = G_; c = c_; }
    __host__ __device__ bool next(int i, Unit& u) const {
        const long L = (long)i * G + c; if (L >= nwg) return false;
        int wgid = (int)L; { const int q = nwg / NXCD, r = nwg % NXCD, xcd = wgid % NXCD, off = wgid / NXCD; wgid = (xcd < r ? xcd * (q + 1) : r * (q + 1) + (xcd - r) * q) + off; }
        const int nig = WGM * nN, gid = wgid / nig, fm = gid * WGM, gsz = (nM - fm) < WGM ? (nM - fm) : WGM;
        u.pm = fm + ((wgid % nig) % gsz); u.pn = (wgid % nig) / gsz; return true;
    }
    __device__ __forceinline__ void a_ready(const Unit&) const {}
    __device__ __forceinline__ void done(const Unit&) const {}
};

template <class Epi, class Sched, bool ALIGN_EPI, bool SP2, bool ATILED = false, bool BTILED = false>
__device__ __forceinline__ void gemm_phase(PG8_LAS unsigned char* lds, const Gemm g, const Sched& S, const Epi& E, const int wid) {
    const int lane = fresh_lane(), tid = wid * 64 + lane, wr = wid >> 2, wc = wid & 3, fr = lane & 15, fq = lane >> 4;
    const int K = g.K, nt = K / BK;
    unsigned voffA[2], voffB[2];
#pragma unroll
    for (int i = 0; i < 2; ++i) { int R, C; stage_rc(tid * 16 + i * 8192, R, C); const int Rb = Epi::PERM ? ((R & ~31) + perm32(R & 31)) : R;
        voffA[i] = (unsigned)(R * (ATILED ? BK : K) + C) * 2u; voffB[i] = (unsigned)(Rb * (BTILED ? BK : K) + C) * 2u; }
    const size_t kstepA = ATILED ? (size_t)(BM * BK * 2) : (size_t)(BK * 2), kstepB = BTILED ? (size_t)(BM * BK * 2) : (size_t)(BK * 2);
    const size_t hstepA = ATILED ? (size_t)(HALF * BK * 2) : (size_t)HALF * K * 2, hstepB = BTILED ? (size_t)(HALF * BK * 2) : (size_t)HALF * K * 2;
    const size_t tstep = (size_t)BM * K * 2;
    const unsigned ldsw = (unsigned)wid * 1024u;
    const int aoff = lds_byte(wr * 64 + fr, fq * 8), boff = lds_byte(wc * 32 + fr, fq * 8);
#define PG8_SA(b, h) (((b) * 2 + (h)) * HTB)
#define PG8_SB(b, h) ((4 + (b) * 2 + (h)) * HTB)
#define PG8_STAGE(bufoff, gbase, voff) do { const char* gb_ = (const char*)(gbase); asm volatile("" : "+s"(gb_));        \
        _Pragma("unroll") for (int _i = 0; _i < 2; ++_i) \
        __builtin_amdgcn_global_load_lds((const unsigned*)(gb_ + (voff)[_i]), (PG8_LAS unsigned*)(lds + (bufoff) + ldsw + _i * 8192), 16, 0, 0); } while (0)
#define PG8_LDA(dst, b, h) do { _Pragma("unroll") for (int m = 0; m < 4; ++m) _Pragma("unroll") for (int k = 0; k < 2; ++k) dst[m][k] = *(const PG8_LAS bf16x8*)(lds + PG8_SA(b, h) + aoff + m * 2048 + k * 1024); } while (0)
#define PG8_LDB(dst, b, h) do { _Pragma("unroll") for (int n = 0; n < 2; ++n) _Pragma("unroll") for (int k = 0; k < 2; ++k) dst[n][k] = *(const PG8_LAS bf16x8*)(lds + PG8_SB(b, h) + boff + n * 2048 + k * 1024); } while (0)
#define PG8_MMA(ai, bj, At, Bt) do { __builtin_amdgcn_s_setprio(1); _Pragma("unroll") for (int m = 0; m < 4; ++m) _Pragma("unroll") for (int n = 0; n < 2; ++n) _Pragma("unroll") for (int k = 0; k < 2; ++k) \
        acc[ai][bj][m][n] = __builtin_amdgcn_mfma_f32_16x16x32_bf16(Bt[n][k], At[m][k], acc[ai][bj][m][n], 0, 0, 0); __builtin_amdgcn_s_setprio(0); } while (0)
#define PG8_WAIT_V(n) asm volatile("s_waitcnt vmcnt(" #n ")" ::: "memory")
#define PG8_WAIT_L(n) asm volatile("s_waitcnt lgkmcnt(" #n ")" ::: "memory")
#define PG8_BAR __builtin_amdgcn_s_barrier()
#define PG8_SCHED __builtin_amdgcn_sched_barrier(0)
    Unit cur, nxt; int ui = 0;
    if (!S.next(0, cur)) return;
    f32x4 acc[2][2][4][2];
#pragma unroll
    for (int a = 0; a < 2; ++a)
#pragma unroll
        for (int b = 0; b < 2; ++b)
#pragma unroll
            for (int m = 0; m < 4; ++m)
#pragma unroll
                for (int n = 0; n < 2; ++n) acc[a][b][m][n] = (f32x4){0.f, 0.f, 0.f, 0.f};
    bf16x8 At[4][2], B0[2][2], B1[2][2];
    const char* cA = (const char*)g.A + (size_t)cur.pm * tstep; const char* cB = (const char*)g.Bt + (size_t)cur.pn * tstep;
    S.a_ready(cur);
    if constexpr (SP2) {
        PG8_STAGE(PG8_SB(0, 0), cB, voffB); PG8_STAGE(PG8_SB(0, 1), cB + hstepB, voffB); PG8_STAGE(PG8_SA(0, 0), cA, voffA); PG8_STAGE(PG8_SA(0, 1), cA + hstepA, voffA);
        if (wr == 1) PG8_BAR;
        PG8_WAIT_V(2); PG8_BAR;
        PG8_STAGE(PG8_SB(1, 0), cB + kstepB, voffB); PG8_STAGE(PG8_SA(1, 0), cA + kstepA, voffA); PG8_STAGE(PG8_SB(1, 1), cB + hstepB + kstepB, voffB);
        PG8_WAIT_V(6); PG8_BAR;
    } else {
        PG8_STAGE(PG8_SB(0, 0), cB, voffB); PG8_STAGE(PG8_SA(0, 0), cA, voffA); PG8_STAGE(PG8_SB(0, 1), cB + hstepB, voffB); PG8_STAGE(PG8_SA(0, 1), cA + hstepA, voffA);
        if (wr == 1) PG8_BAR;
        PG8_WAIT_V(4); PG8_BAR;
        PG8_STAGE(PG8_SB(1, 0), cB + kstepB, voffB); PG8_STAGE(PG8_SA(1, 0), cA + kstepA, voffA); PG8_STAGE(PG8_SB(1, 1), cB + hstepB + kstepB, voffB);
        PG8_WAIT_V(6); PG8_BAR;
    }
    for (;;) {
        const bool has_next = S.next(ui + 1, nxt);
        const char* nA = has_next ? (const char*)g.A + (size_t)nxt.pm * tstep : cA; const char* nB = has_next ? (const char*)g.Bt + (size_t)nxt.pn * tstep : cB;
#pragma clang loop unroll(disable)
        for (int t = 0; t < nt; t += 2) {
            const bool last = (t == nt - 2);
            const char* a1 = cA + (size_t)(t + 1) * kstepA;
            const char* a2 = last ? nA : cA + (size_t)(t + 2) * kstepA; const char* b2 = last ? nB : cB + (size_t)(t + 2) * kstepB;
            const char* a3 = a2 + kstepA; const char* b3 = b2 + kstepB;
            if (last && has_next) S.a_ready(nxt);
            if constexpr (SP2) {
            asm volatile("" : "+v"(voffA[0]), "+v"(voffA[1]), "+v"(voffB[0]), "+v"(voffB[1]));
            PG8_LDB(B0, 0, 0); PG8_LDB(B1, 0, 1); PG8_SCHED; PG8_LDA(At, 0, 0); PG8_STAGE(PG8_SA(1, 1), a1 + hstepA, voffA);
            PG8_WAIT_V(8); PG8_WAIT_L(0); PG8_BAR; PG8_MMA(0, 0, At, B0); PG8_MMA(0, 1, At, B1); PG8_BAR; PG8_SCHED;
            PG8_LDA(At, 0, 1); PG8_STAGE(PG8_SB(0, 0), b2, voffB); PG8_STAGE(PG8_SB(0, 1), b2 + hstepB, voffB); PG8_STAGE(PG8_SA(0, 0), a2, voffA);
            PG8_WAIT_V(8); PG8_WAIT_L(0); PG8_BAR; PG8_MMA(1, 0, At, B0); PG8_MMA(1, 1, At, B1); PG8_BAR; PG8_SCHED;
            PG8_LDB(B0, 1, 0); PG8_LDB(B1, 1, 1); PG8_SCHED; PG8_LDA(At, 1, 0); PG8_STAGE(PG8_SA(0, 1), a2 + hstepA, voffA);
            PG8_WAIT_V(8); PG8_WAIT_L(0); PG8_BAR; PG8_MMA(0, 0, At, B0); PG8_MMA(0, 1, At, B1); PG8_BAR; PG8_SCHED;
            PG8_LDA(At, 1, 1); PG8_STAGE(PG8_SB(1, 0), b3, voffB); PG8_STAGE(PG8_SB(1, 1), b3 + hstepB, voffB); PG8_STAGE(PG8_SA(1, 0), a3, voffA);
            PG8_WAIT_V(8); PG8_WAIT_L(0); PG8_BAR; PG8_MMA(1, 0, At, B0); PG8_MMA(1, 1, At, B1); PG8_BAR; PG8_SCHED;
            } else {
            PG8_LDB(B0, 0, 0); PG8_SCHED; PG8_LDA(At, 0, 0); PG8_STAGE(PG8_SA(1, 1), a1 + hstepA, voffA);
            PG8_WAIT_L(8); PG8_BAR; PG8_WAIT_L(0); PG8_MMA(0, 0, At, B0); PG8_BAR; PG8_SCHED;
            PG8_LDB(B1, 0, 1); PG8_STAGE(PG8_SB(0, 0), b2, voffB);
            PG8_BAR; PG8_WAIT_L(0); PG8_MMA(0, 1, At, B1); PG8_BAR;
            PG8_LDA(At, 0, 1); PG8_STAGE(PG8_SA(0, 0), a2, voffA);
            PG8_BAR; PG8_WAIT_L(0); PG8_MMA(1, 0, At, B0); PG8_BAR; PG8_SCHED;
            PG8_STAGE(PG8_SB(0, 1), b2 + hstepB, voffB);
            PG8_WAIT_V(6); PG8_BAR; PG8_MMA(1, 1, At, B1); PG8_BAR;
            PG8_LDB(B0, 1, 0); PG8_SCHED; PG8_LDA(At, 1, 0); PG8_STAGE(PG8_SA(0, 1), a2 + hstepA, voffA);
            PG8_WAIT_L(8); PG8_BAR; PG8_WAIT_L(0); PG8_MMA(0, 0, At, B0); PG8_BAR; PG8_SCHED;
            PG8_LDB(B1, 1, 1); PG8_STAGE(PG8_SB(1, 0), b3, voffB);
            PG8_BAR; PG8_WAIT_L(0); PG8_MMA(0, 1, At, B1); PG8_BAR;
            PG8_LDA(At, 1, 1); PG8_STAGE(PG8_SA(1, 0), a3, voffA);
            PG8_BAR; PG8_WAIT_L(0); PG8_MMA(1, 0, At, B0); PG8_BAR; PG8_SCHED;
            PG8_STAGE(PG8_SB(1, 1), b3 + hstepB, voffB);
            PG8_WAIT_V(6); PG8_BAR; PG8_MMA(1, 1, At, B1); PG8_BAR;
            }
        }
        if constexpr (ALIGN_EPI) { if (wr == 0) PG8_BAR; }
        E(acc, cur, wr, wc, fr, fq); S.done(cur);
        if (!has_next) break;
#pragma unroll
        for (int a = 0; a < 2; ++a)
#pragma unroll
            for (int b = 0; b < 2; ++b)
#pragma unroll
                for (int m = 0; m < 4; ++m)
#pragma unroll
                    for (int n = 0; n < 2; ++n) acc[a][b][m][n] = (f32x4){0.f, 0.f, 0.f, 0.f};
        cur = nxt; cA = nA; cB = nB; ++ui;
        if constexpr (ALIGN_EPI) { if (wr == 1) PG8_BAR; }
    }
    PG8_WAIT_V(0);
    if constexpr (!ALIGN_EPI) { if (wr == 0) PG8_BAR; }
    PG8_BAR;
#undef PG8_SA
#undef PG8_SB
#undef PG8_STAGE
#undef PG8_LDA
#undef PG8_LDB
#undef PG8_MMA
#undef PG8_WAIT_V
#undef PG8_WAIT_L
#undef PG8_BAR
#undef PG8_SCHED
}
}

constexpr int NWAVES = 8;
constexpr int MTOK = 32768, DM = 2048, DFF = 5632, NGU = 2 * DFF, SEQ = 2048, NBATCH = 16;
constexpr float NORM_EPS = 1e-6f;
constexpr float LAMBDA_INIT = 0.35550906759096926f;
constexpr float QSCALE = 0.08838834764831845f;
constexpr size_t MiB = (size_t)1 << 20;
constexpr size_t WS_CTL = 0, CTL_ZERO_BYTES = 32768;
constexpr size_t WS_TAB = 4 * MiB;
constexpr size_t WS_W = 8 * MiB;
constexpr size_t W_GU = 0, W_DN = 176 * MiB, W_HIN = 264 * MiB, W_HOUT = 296 * MiB, W_KV = 304 * MiB, W_Q = 320 * MiB, W_AO = 328 * MiB, W_PG = 336 * MiB, W_PP = 352 * MiB;
constexpr size_t WS_PB = 364 * MiB;
constexpr size_t WS_HB1 = 396 * MiB, WS_HB2 = 524 * MiB;
constexpr size_t WS_BIG = 652 * MiB;
constexpr size_t WS_STATS = WS_BIG + 640 * MiB;
constexpr size_t WS_END = WS_STATS + 9 * MiB;
constexpr size_t BIG_HID = 0;
constexpr size_t BIG_HQ = 0, BIG_HV = 128 * MiB, BIG_HSG = 256 * MiB, BIG_HLF = 384 * MiB;
constexpr size_t BIG_PP = 384 * MiB;
constexpr size_t BIG_KR = 384 * MiB, BIG_VV = 512 * MiB;
constexpr size_t BIG_QR = 0, BIG_O1 = 128 * MiB, BIG_O2 = 256 * MiB;
constexpr int CW_TMO = 0, CW_CODE = 1, CW_BAR = 4096;

constexpr int RING_OFF = 0, RING_BYTES = 131072;
constexpr int RSTAB_OFF = 131072;
constexpr int LDSCTL_OFF = 147456, MISC_OFF = LDSCTL_OFF + 320;
constexpr int RED_OFF = 148480;
constexpr int LDS_BYTES = 152576;

#define GAS __attribute__((address_space(1)))
#define LAS __attribute__((address_space(3)))
typedef unsigned short bf16;
typedef unsigned v4u __attribute__((ext_vector_type(4)));
typedef unsigned v2u __attribute__((ext_vector_type(2)));
typedef float f32x4 __attribute__((ext_vector_type(4)));
typedef short bf16x8 __attribute__((ext_vector_type(8)));
typedef short s16x4 __attribute__((ext_vector_type(4)));
typedef float f32x2_t __attribute__((ext_vector_type(2)));
typedef __bf16 bf16x2_t __attribute__((ext_vector_type(2)));
typedef GAS unsigned gu32;
typedef unsigned long long u64;
#define RLX_AGENT __ATOMIC_RELAXED, __HIP_MEMORY_SCOPE_AGENT
#define LDS_WAIT() asm volatile("s_waitcnt lgkmcnt(0)" ::: "memory")
#define VM_WAIT() asm volatile("s_waitcnt vmcnt(0)" ::: "memory")
__device__ __forceinline__ unsigned pk2(float lo, float hi) { f32x2_t v = {lo, hi}; bf16x2_t b = __builtin_convertvector(v, bf16x2_t); return __builtin_bit_cast(unsigned, b); }
__device__ __forceinline__ float bf2f(unsigned short b) { return __uint_as_float(((unsigned)b) << 16); }
__device__ __forceinline__ float bflo(unsigned w) { return __uint_as_float(w << 16); }
__device__ __forceinline__ float bfhi(unsigned w) { return __uint_as_float(w & 0xffff0000u); }
__device__ __forceinline__ float fast_sigmoid(float x) { return __builtin_amdgcn_rcpf(1.0f + __builtin_amdgcn_exp2f(-1.4426950408889634f * x)); }
__device__ __forceinline__ float wave_sum(float v) {
#pragma unroll
    for (int o = 1; o < 64; o <<= 1) v += __shfl_xor(v, o);
    return v;
}
__device__ __forceinline__ float stat_rstd(const float* st, int row) {
    float s = 0.f;
#pragma unroll
    for (int p = 0; p < 8; ++p) s += st[(size_t)p * MTOK + row];
    return rsqrtf(s * (1.0f / (float)DM) + NORM_EPS);
}
__device__ __forceinline__ void fill_rstd_table(LAS float* tab, const float* st, int c, int wid) {
    const int tid = wid * 64 + fresh_lane(), base = 4096 * (c & 7);
    float r[8];
#pragma unroll
    for (int i = 0; i < 8; ++i) r[i] = stat_rstd(st, base + tid + 512 * i);
#pragma unroll
    for (int i = 0; i < 8; ++i) tab[tid + 512 * i] = r[i];
    asm volatile("s_waitcnt lgkmcnt(0)" ::: "memory"); __syncthreads();
}
#define XB_TMO      128
#define XB_XCNT(j)  (256  + 64 * (j))
#define XB_XSUB(j)  (1280 + 64 * (j))
#define XB_XGEN(j)  (2304 + 64 * (j))
#define XB_TOP      3328
#define XB_TOPGEN   3392
#define XCD_BAR_WORDS 3456
#define XB_SPIN_CAP (1u << 18)
__device__ __forceinline__ unsigned xb_ld(unsigned* p)              { return __hip_atomic_load(p, __ATOMIC_RELAXED, __HIP_MEMORY_SCOPE_AGENT); }
__device__ __forceinline__ unsigned xb_add(unsigned* p, unsigned v) { return __hip_atomic_fetch_add(p, v, __ATOMIC_RELAXED, __HIP_MEMORY_SCOPE_AGENT); }
__device__ __forceinline__ unsigned xb_xcc_id() { return (unsigned)__builtin_amdgcn_s_getreg((3 << 11) | 20) & 0xFu; }
#define XB_SPIN(cond, bar) do { unsigned _sp = 0; while (cond) { __builtin_amdgcn_s_sleep(1); \
    if ((++_sp & 255u) == 0u) { if (xb_ld(&(bar)[XB_TMO])) break; if (_sp > XB_SPIN_CAP) { atomicAdd(&(bar)[XB_TMO], 1u); break; } } } } while (0)
struct XcdBarrier { unsigned* bar; unsigned x; volatile LAS unsigned* st; };
__device__ __forceinline__ XcdBarrier xcd_barrier_post(unsigned* bar, volatile LAS unsigned* st, int wid) {
    XcdBarrier b; b.bar = bar; b.x = xb_xcc_id(); b.st = st;
    if (wid == 0 && fresh_lane() == 0) (void)xb_add(&bar[XB_XCNT(b.x)], 1u);
    return b;
}
__device__ __forceinline__ void xcd_barrier_complete(unsigned* bar, unsigned x, unsigned& nloc, unsigned& nx) {
    const unsigned G = gridDim.x * gridDim.y * gridDim.z;
    unsigned sum, cnt, mine, sp = 0u;
    for (;;) {
        sum = 0u; cnt = 0u; mine = 0u;
#pragma unroll
        for (unsigned j = 0; j < 16; ++j) { const unsigned c = xb_ld(&bar[XB_XCNT(j)]); sum += c; cnt += (c > 0u) ? 1u : 0u; mine = (j == x) ? c : mine; }
        if (sum == G) break;
        __builtin_amdgcn_s_sleep(1);
        if ((++sp & 255u) == 0u) { if (xb_ld(&bar[XB_TMO])) break; if (sp > XB_SPIN_CAP) { atomicAdd(&bar[XB_TMO], 1u); break; } }
    }
    nloc = mine > 0u ? mine : 1u; nx = cnt > 0u ? cnt : 1u;
}
__device__ __forceinline__ void xcd_barrier(const XcdBarrier& b, int wid) {
    asm volatile("s_waitcnt vmcnt(0)" ::: "memory");
    __syncthreads();
    if (wid == 0 && fresh_lane() == 0) {
        unsigned* bar = b.bar;
        __builtin_amdgcn_s_waitcnt(0);
        unsigned nloc = b.st[0], nx = b.st[1];
        if (nloc == 0u) { xcd_barrier_complete(bar, b.x, nloc, nx); b.st[0] = nloc; b.st[1] = nx; }
        const unsigned old = xb_add(&bar[XB_XSUB(b.x)], 1u);
        const unsigned gen = old / nloc;
        if (old + 1u == (gen + 1u) * nloc) {
            __builtin_amdgcn_fence(__ATOMIC_RELEASE, "agent");
            asm volatile("s_waitcnt vmcnt(0)" ::: "memory");
            const unsigned og = xb_add(&bar[XB_TOP], 1u);
            const unsigned tg = og / nx;
            if (og + 1u == (tg + 1u) * nx) xb_add(&bar[XB_TOPGEN], 1u);
            else XB_SPIN(xb_ld(&bar[XB_TOPGEN]) == tg, bar);
            __builtin_amdgcn_fence(__ATOMIC_ACQUIRE, "agent");
            xb_add(&bar[XB_XGEN(b.x)], 1u);
            asm volatile("s_waitcnt vmcnt(0)" ::: "memory");
        } else {
            XB_SPIN(xb_ld(&bar[XB_XGEN(b.x)]) == gen, bar);
            __builtin_amdgcn_fence(__ATOMIC_ACQUIRE, "agent");
            asm volatile("s_waitcnt vmcnt(0)" ::: "memory");
        }
    }
    __syncthreads();
}

__device__ __forceinline__ float scan16(float x) {
    x += __builtin_bit_cast(float, __builtin_amdgcn_update_dpp(0, __builtin_bit_cast(int, x), 0x111, 0xf, 0xf, true));
    x += __builtin_bit_cast(float, __builtin_amdgcn_update_dpp(0, __builtin_bit_cast(int, x), 0x112, 0xf, 0xf, true));
    x += __builtin_bit_cast(float, __builtin_amdgcn_update_dpp(0, __builtin_bit_cast(int, x), 0x114, 0xf, 0xf, true));
    x += __builtin_bit_cast(float, __builtin_amdgcn_update_dpp(0, __builtin_bit_cast(int, x), 0x118, 0xf, 0xf, true));
    return x;
}
using pg8::Unit;
struct EpiGU {
    static constexpr bool PERM = true;
    bf16* HID; const LAS float* rt;
    __device__ __forceinline__ void operator()(const f32x4 (&acc)[2][2][4][2], const Unit& u, int wr, int wc, int fr, int fq) const {
        const int row0 = u.pm * 256 + wr * 64 + fr, hc = u.pn * 128 + wc * 32 + 8 * fq;
        float rsv[2][4];
#pragma unroll
        for (int ai = 0; ai < 2; ++ai)
#pragma unroll
            for (int m = 0; m < 4; ++m) rsv[ai][m] = rt[(row0 + ai * 128 + m * 16) & 4095];
#pragma unroll
        for (int ai = 0; ai < 2; ++ai)
#pragma unroll
            for (int m = 0; m < 4; ++m) { const int row = row0 + ai * 128 + m * 16; const float rs = rsv[ai][m], rs2 = rs * rs, rsl = -1.4426950408889634f * rs;
                float h[8];
#pragma unroll
                for (int n = 0; n < 2; ++n)
#pragma unroll
                    for (int j = 0; j < 4; ++j) { const float ga = acc[ai][0][m][n][j], ua = acc[ai][1][m][n][j];
                        h[4 * n + j] = (ga * ua) * rs2 * __builtin_amdgcn_rcpf(1.0f + __builtin_amdgcn_exp2f(ga * rsl)); }
                v4u w; w.x = pk2(h[0], h[1]); w.y = pk2(h[2], h[3]); w.z = pk2(h[4], h[5]); w.w = pk2(h[6], h[7]);
                __builtin_nontemporal_store(w, (v4u*)(HID + (size_t)(row >> 8) * (256 * DFF) + (size_t)(hc >> 6) * 16384 + (row & 255) * 64 + (hc & 63))); }
    }
};
__device__ __forceinline__ void row_stat_store(LAS float* red, float* st, const Unit& u, int wr, int wc, int fr, int fq, const float (&part)[2][4]) {
    if (fq == 0) {
#pragma unroll
        for (int ai = 0; ai < 2; ++ai)
#pragma unroll
            for (int m = 0; m < 4; ++m) red[wc * 256 + ai * 128 + wr * 64 + m * 16 + fr] = part[ai][m];
    }
    asm volatile("s_waitcnt lgkmcnt(0)" ::: "memory"); __builtin_amdgcn_s_barrier(); asm volatile("" ::: "memory");
    const int t = (wr * 4 + wc) * 64 + fq * 16 + fr;
    if (t < 256) { const float sum = (red[t] + red[256 + t]) + (red[512 + t] + red[768 + t]); st[(size_t)u.pn * MTOK + u.pm * 256 + t] = sum; }
}
template <bool F32BASE> struct EpiRes {
    static constexpr bool PERM = true;
    const void* basep; bf16* HB; float* st; float alpha; LAS float* red;
    __device__ __forceinline__ void operator()(const f32x4 (&acc)[2][2][4][2], const Unit& u, int wr, int wc, int fr, int fq) const {
        const int row0 = u.pm * 256 + wr * 64 + fr, c0 = u.pn * 256 + wc * 32 + 8 * fq;
        float part[2][4];
        constexpr int NB = F32BASE ? 2 : 4, NG = 8 / NB, GPA = 4 / NB;
        v4u raw[2][NB][2]; f32x4 bf[2][NB][2][2];
#define RES_LOAD(g, sl) do { _Pragma("unroll") for (int mm = 0; mm < NB; ++mm) { const size_t off = (size_t)(row0 + ((g) / GPA) * 128 + (((g) % GPA) * NB + mm) * 16) * DM + c0; \
            _Pragma("unroll") for (int bj = 0; bj < 2; ++bj) { \
                if constexpr (F32BASE) { const float* base = (const float*)basep; bf[sl][mm][bj][0] = *(const f32x4*)(base + off + bj * 128); bf[sl][mm][bj][1] = *(const f32x4*)(base + off + bj * 128 + 4); } \
                else raw[sl][mm][bj] = *(const v4u*)((const bf16*)basep + off + bj * 128); } } } while (0)
        RES_LOAD(0, 0);
#pragma unroll
        for (int g = 0; g < NG; ++g) { const int ai = g / GPA, mb = g % GPA, sl = g & 1;
            if (g + 1 < NG) RES_LOAD(g + 1, (g + 1) & 1);
#pragma unroll
            for (int mm = 0; mm < NB; ++mm) { const int m = mb * NB + mm; const int row = row0 + ai * 128 + m * 16; const size_t off = (size_t)row * DM + c0; float ss = 0.f;
#pragma unroll
                for (int bj = 0; bj < 2; ++bj) { f32x4 b0, b1;
                    if constexpr (F32BASE) { b0 = bf[sl][mm][bj][0]; b1 = bf[sl][mm][bj][1]; }
                    else { const v4u r = raw[sl][mm][bj]; b0 = (f32x4){bflo(r.x), bfhi(r.x), bflo(r.y), bfhi(r.y)}; b1 = (f32x4){bflo(r.z), bfhi(r.z), bflo(r.w), bfhi(r.w)}; }
                    const f32x4 v0 = b0 + alpha * acc[ai][bj][m][0], v1 = b1 + alpha * acc[ai][bj][m][1];
                    v4u w; w.x = pk2(v0[0], v0[1]); w.y = pk2(v0[2], v0[3]); w.z = pk2(v1[0], v1[1]); w.w = pk2(v1[2], v1[3]);
                    *(v4u*)(HB + off + bj * 128) = w;
                    ss += (v0[0] * v0[0] + v0[1] * v0[1]) + (v0[2] * v0[2] + v0[3] * v0[3]) + (v1[0] * v1[0] + v1[1] * v1[1]) + (v1[2] * v1[2] + v1[3] * v1[3]); }
                ss += __shfl_xor(ss, 16); ss += __shfl_xor(ss, 32); part[ai][m] = ss; }
            asm volatile("" ::: "memory"); }
#undef RES_LOAD
        row_stat_store(red, st, u, wr, wc, fr, fq, part);
    }
};
struct EpiPleG {
    static constexpr bool PERM = true;
    const bf16* base; bf16* HB; float* st; const LAS float* rt; const bf16* PP; LAS float* red;
    __device__ __forceinline__ void operator()(const f32x4 (&acc)[2][2][4][2], const Unit& u, int wr, int wc, int fr, int fq) const {
        const int row0 = u.pm * 256 + wr * 64 + fr, c0 = u.pn * 256 + wc * 32 + 8 * fq;
        float part[2][4];
        v4u bv[2][2][2], pv[2][2][2];
#define PG_LOAD(g, sl) do { _Pragma("unroll") for (int mm = 0; mm < 2; ++mm) { const int row = row0 + ((g) >> 1) * 128 + (2 * ((g) & 1) + mm) * 16; const size_t off = (size_t)row * DM + c0; \
            _Pragma("unroll") for (int bj = 0; bj < 2; ++bj) { bv[sl][mm][bj] = *(const v4u*)(base + off + bj * 128); pv[sl][mm][bj] = *(const v4u*)(PP + off + bj * 128); } } } while (0)
        PG_LOAD(0, 0);
#pragma unroll
        for (int g = 0; g < 4; ++g) { const int ai = g >> 1, mb = g & 1, sl = g & 1;
            if (g + 1 < 4) PG_LOAD(g + 1, (g + 1) & 1);
#pragma unroll
            for (int mm = 0; mm < 2; ++mm) { const int m = 2 * mb + mm; const int row = row0 + ai * 128 + m * 16; const size_t off = (size_t)row * DM + c0; float ss = 0.f;
                const float rs = rt[row & 4095];
#pragma unroll
                for (int bj = 0; bj < 2; ++bj) { const v4u b = bv[sl][mm][bj], p = pv[sl][mm][bj];
                    const float bb[8] = {bflo(b.x), bfhi(b.x), bflo(b.y), bfhi(b.y), bflo(b.z), bfhi(b.z), bflo(b.w), bfhi(b.w)};
                    const float pp[8] = {bflo(p.x), bfhi(p.x), bflo(p.y), bfhi(p.y), bflo(p.z), bfhi(p.z), bflo(p.w), bfhi(p.w)};
                    float v[8];
#pragma unroll
                    for (int n = 0; n < 2; ++n)
#pragma unroll
                        for (int j = 0; j < 4; ++j) { v[4 * n + j] = bb[4 * n + j] + fast_sigmoid(acc[ai][bj][m][n][j] * rs) * pp[4 * n + j]; ss += v[4 * n + j] * v[4 * n + j]; }
                    v4u w; w.x = pk2(v[0], v[1]); w.y = pk2(v[2], v[3]); w.z = pk2(v[4], v[5]); w.w = pk2(v[6], v[7]);
                    *(v4u*)(HB + off + bj * 128) = w; }
                ss += __shfl_xor(ss, 16); ss += __shfl_xor(ss, 32); part[ai][m] = ss; }
            asm volatile("" ::: "memory"); }
#undef PG_LOAD
        row_stat_store(red, st, u, wr, wc, fr, fq, part);
    }
};
struct EpiPlain {
    static constexpr bool PERM = true;
    bf16* C;
    __device__ __forceinline__ void operator()(const f32x4 (&acc)[2][2][4][2], const Unit& u, int wr, int wc, int fr, int fq) const {
        const int row0 = u.pm * 256 + wr * 64 + fr, c0 = u.pn * 256 + wc * 32 + 8 * fq;
#pragma unroll
        for (int ai = 0; ai < 2; ++ai)
#pragma unroll
            for (int m = 0; m < 4; ++m) { bf16* rp = C + (size_t)(row0 + ai * 128 + m * 16) * DM + c0;
#pragma unroll
                for (int bj = 0; bj < 2; ++bj) { const f32x4 a = acc[ai][bj][m][0], b = acc[ai][bj][m][1];
                    v4u w; w.x = pk2(a[0], a[1]); w.y = pk2(a[2], a[3]); w.z = pk2(b[0], b[1]); w.w = pk2(b[2], b[3]);
                    *(v4u*)(rp + bj * 128) = w; } }
    }
};
struct EpiHgIn {
    static constexpr bool PERM = true;
    bf16* Q; float* LF; bf16* V; bf16* SG; const LAS float* rt; const float* lb;
    __device__ __forceinline__ void operator()(const f32x4 (&acc)[2][2][4][2], const Unit& u, int wr, int wc, int fr, int fq) const {
        const int region = u.pn >> 3; const int row0 = u.pm * 256 + wr * 64 + fr, c0 = (u.pn & 7) * 256 + wc * 32 + 8 * fq;
        float rsv[2][4];
#pragma unroll
        for (int ai = 0; ai < 2; ++ai)
#pragma unroll
            for (int m = 0; m < 4; ++m) rsv[ai][m] = rt[(row0 + ai * 128 + m * 16) & 4095];
        if (region == 1) {
            f32x4 lbv[2][2];
#pragma unroll
            for (int bj = 0; bj < 2; ++bj) { lbv[bj][0] = *(const f32x4*)(lb + c0 + bj * 128); lbv[bj][1] = *(const f32x4*)(lb + c0 + bj * 128 + 4); }
            const int src15 = fq * 16 + 15;
#pragma unroll
            for (int ai = 0; ai < 2; ++ai)
#pragma unroll
                for (int mp = 0; mp < 2; ++mp) { const int rowa = row0 + ai * 128 + (2 * mp) * 16, rowb = rowa + 16; const float rsa = rsv[ai][2 * mp], rsb = rsv[ai][2 * mp + 1];
#pragma unroll
                    for (int bj = 0; bj < 2; ++bj) { float xa[8], xb[8];
#pragma unroll
                        for (int n = 0; n < 2; ++n)
#pragma unroll
                            for (int j = 0; j < 4; ++j) { const float l = lbv[bj][n][j], om = 1.0f - l;
                                const float sa = fast_sigmoid(acc[ai][bj][2 * mp][n][j] * rsa), sb = fast_sigmoid(acc[ai][bj][2 * mp + 1][n][j] * rsb);
                                xa[4 * n + j] = __logf(l + om * sa); xb[4 * n + j] = __logf(l + om * sb); }
#pragma unroll
                        for (int e = 0; e < 8; ++e) { xa[e] = scan16(xa[e]); xb[e] = scan16(xb[e]) + __shfl(xa[e], src15); }
                        float* pa = LF + (size_t)rowa * DM + c0 + bj * 128; float* pb = LF + (size_t)rowb * DM + c0 + bj * 128;
                        __builtin_nontemporal_store((f32x4){xa[0], xa[1], xa[2], xa[3]}, (f32x4*)pa); __builtin_nontemporal_store((f32x4){xa[4], xa[5], xa[6], xa[7]}, (f32x4*)(pa + 4));
                        __builtin_nontemporal_store((f32x4){xb[0], xb[1], xb[2], xb[3]}, (f32x4*)pb); __builtin_nontemporal_store((f32x4){xb[4], xb[5], xb[6], xb[7]}, (f32x4*)(pb + 4));
 } }
        } else {
            const size_t roff = region == 0 ? 0 : (region == 2 ? (size_t)(BIG_HV - BIG_HQ) : (size_t)(BIG_HSG - BIG_HQ));
            bf16* O = (bf16*)((unsigned char*)Q + roff);
#pragma unroll
            for (int ai = 0; ai < 2; ++ai)
#pragma unroll
                for (int m = 0; m < 4; ++m) { const int row = row0 + ai * 128 + m * 16; const float rs = rsv[ai][m]; bf16* rp = O + (size_t)row * DM + c0;
#pragma unroll
                    for (int bj = 0; bj < 2; ++bj) { float h[8];
#pragma unroll
                        for (int n = 0; n < 2; ++n)
#pragma unroll
                            for (int j = 0; j < 4; ++j) { float x = acc[ai][bj][m][n][j] * rs; if (region == 3) x = x * fast_sigmoid(x); h[4 * n + j] = x; }
                        v4u w; w.x = pk2(h[0], h[1]); w.y = pk2(h[2], h[3]); w.z = pk2(h[4], h[5]); w.w = pk2(h[6], h[7]);
                        __builtin_nontemporal_store(w, (v4u*)(rp + bj * 128)); } }
        }
    }
};
struct EpiRope {
    static constexpr bool PERM = true;
    bf16* O; bf16* V2; int nrope; const LAS float* rt; const float* cs; const float* sn;
    __device__ __forceinline__ void operator()(const f32x4 (&acc)[2][2][4][2], const Unit& u, int wr, int wc, int fr, int fq) const {
        const int row0 = u.pm * 256 + wr * 64 + fr;
        float rsv[2][4];
#pragma unroll
        for (int ai = 0; ai < 2; ++ai)
#pragma unroll
            for (int m = 0; m < 4; ++m) rsv[ai][m] = rt[(row0 + ai * 128 + m * 16) & 4095];
        if (u.pn < nrope) {
            const int comp = wc >> 1, dl = 32 * (wc & 1) + 8 * fq, oc = u.pn * 256 + comp * 128 + dl;
#pragma unroll
            for (int ai = 0; ai < 2; ++ai) {
                f32x4 cv[4][2], sv[4][2];
#pragma unroll
                for (int m = 0; m < 4; ++m) { const int pos = (row0 + ai * 128 + m * 16) & (SEQ - 1);
#pragma unroll
                    for (int n = 0; n < 2; ++n) { cv[m][n] = *(const f32x4*)(cs + pos * 64 + dl + 4 * n); sv[m][n] = *(const f32x4*)(sn + pos * 64 + dl + 4 * n); } }
#pragma unroll
                for (int m = 0; m < 4; ++m) { const int row = row0 + ai * 128 + m * 16; const float rs = rsv[ai][m];
                    float o1[8], o2[8];
#pragma unroll
                    for (int n = 0; n < 2; ++n) {
#pragma unroll
                        for (int j = 0; j < 4; ++j) { const float x1 = acc[ai][0][m][n][j] * rs, x2 = acc[ai][1][m][n][j] * rs; const float c = cv[m][n][j], sj = sv[m][n][j]; o1[4 * n + j] = x1 * c - x2 * sj; o2[4 * n + j] = x2 * c + x1 * sj; } }
                    v4u w1, w2; w1.x = pk2(o1[0], o1[1]); w1.y = pk2(o1[2], o1[3]); w1.z = pk2(o1[4], o1[5]); w1.w = pk2(o1[6], o1[7]);
                    w2.x = pk2(o2[0], o2[1]); w2.y = pk2(o2[2], o2[3]); w2.z = pk2(o2[4], o2[5]); w2.w = pk2(o2[6], o2[7]);
                    bf16* rp = O + (size_t)row * DM + oc; __builtin_nontemporal_store(w1, (v4u*)rp); __builtin_nontemporal_store(w2, (v4u*)(rp + 64)); } }
        } else {
            const int c0 = (u.pn - nrope) * 256 + wc * 32 + 8 * fq;
#pragma unroll
            for (int ai = 0; ai < 2; ++ai)
#pragma unroll
                for (int m = 0; m < 4; ++m) { const int row = row0 + ai * 128 + m * 16; const float rs = rsv[ai][m]; bf16* rp = V2 + (size_t)row * DM + c0;
#pragma unroll
                    for (int bj = 0; bj < 2; ++bj) { const f32x4 a = acc[ai][bj][m][0] * rs, b = acc[ai][bj][m][1] * rs;
                        v4u w; w.x = pk2(a[0], a[1]); w.y = pk2(a[2], a[3]); w.z = pk2(b[0], b[1]); w.w = pk2(b[2], b[3]);
                        __builtin_nontemporal_store(w, (v4u*)(rp + bj * 128)); } }
        }
    }
};

namespace att {
constexpr int D = 128, LDX = 2048;
constexpr float SCALE = 0.08838834764831845f;
constexpr float THR = 8.f;
constexpr int NW = 8, QBLK = 32, KVBLK = 64, QB = NW * QBLK;
constexpr int SHM_V = KVBLK * 256 * 2, SHM_K = KVBLK * D * 2;
constexpr int LDS_ATT = 2 * SHM_V + 2 * SHM_K + NW * 64 * 4;
typedef float f32x16 __attribute__((ext_vector_type(16)));
typedef unsigned u32x4 __attribute__((ext_vector_type(4)));
#define KSWZ(row, colB) ((row) * 256 + ((colB) ^ (((row) & 7) << 4)))
#define SBAR() __builtin_amdgcn_sched_barrier(0)
__device__ __forceinline__ int v_st(int k, int c) { const int kk = (k & ~0xC) | ((k & 4) << 1) | ((k & 8) >> 1); return ((kk >> 3) * 4 + (c >> 5)) * 512 + ((kk & 7) * 32 + (c & 31)) * 2; }
__device__ __forceinline__ int v_rd_base(int lane) { return ((lane & 3) << 3) | (((lane >> 2) & 3) << 6) | (((lane >> 4) & 1) << 5) | (((lane >> 5) & 1) << 8); }
constexpr int v_rd_off(int d0, int ks, int half) { return d0 * 512 + ks * 4096 + half * 2048; }
__device__ __forceinline__ int crow(int r, int hi) { return (r & 3) + 8 * (r >> 2) + 4 * hi; }
__device__ __forceinline__ unsigned cvtpk(float lo, float hi) { return pk2(lo, hi); }
__device__ __forceinline__ bf16x8 load8(const bf16* p) { return *reinterpret_cast<const bf16x8*>(p); }
__device__ __forceinline__ void mask_tile(f32x16& p0, f32x16& p1, int dq, unsigned W) {
    const float NEG = -__builtin_inff();
#pragma unroll
    for (int r = 0; r < 16; ++r) {
        const int c = (r & 3) + 8 * (r >> 2);
        if ((unsigned)(dq - c) >= W) p0[r] = NEG;
        if ((unsigned)(dq - c - 32) >= W) p1[r] = NEG;
    }
}
__device__ __forceinline__ void partialSM(f32x16& p0, f32x16& p1, float& m_reg, float& mn, float& alpha) {
    float pmax = p0[0]; for (int r = 1; r < 16; ++r) pmax = fmaxf(pmax, p0[r]); for (int r = 0; r < 16; ++r) pmax = fmaxf(pmax, p1[r]);
    { auto rr = __builtin_amdgcn_permlane32_swap(__float_as_uint(pmax), __float_as_uint(pmax), false, false);
      pmax = fmaxf(__uint_as_float(rr[0]), __uint_as_float(rr[1])); }
    constexpr float C2 = 1.4426950408889634f * SCALE;
    if (__builtin_expect(__all((pmax - m_reg) * SCALE <= THR), 1)) { mn = m_reg; alpha = 1.f; }
    else { mn = fmaxf(m_reg, pmax); alpha = __builtin_amdgcn_exp2f((m_reg - mn) * C2); m_reg = mn; }
    const float mnL = -mn * C2;
    for (int r = 0; r < 16; ++r) p0[r] = fmaf(p0[r], C2, mnL); for (int r = 0; r < 16; ++r) p1[r] = fmaf(p1[r], C2, mnL);
    for (int r = 0; r < 16; ++r) p0[r] = __builtin_amdgcn_exp2f(p0[r]);
}
__device__ __forceinline__ void finishSM(f32x16& p0, f32x16& p1, float alpha, float& l_reg, bf16x8& pa0, bf16x8& pa1, bf16x8& pa2, bf16x8& pa3) {
    for (int r = 0; r < 16; ++r) p1[r] = __builtin_amdgcn_exp2f(p1[r]);
    float ps = 0; for (int r = 0; r < 16; ++r) ps += p0[r]; for (int r = 0; r < 16; ++r) ps += p1[r];
    { auto rr = __builtin_amdgcn_permlane32_swap(__float_as_uint(ps), __float_as_uint(ps), false, false);
      ps = __uint_as_float(rr[0]) + __uint_as_float(rr[1]); }
    l_reg = l_reg * alpha + ps;
#define PK4(P, B_, OUT) do { unsigned a0 = cvtpk(P[B_+0], P[B_+1]), a1 = cvtpk(P[B_+2], P[B_+3]);                          \
        unsigned b0 = cvtpk(P[B_+4], P[B_+5]), b1 = cvtpk(P[B_+6], P[B_+7]);                                             \
        auto r0 = __builtin_amdgcn_permlane32_swap(a0, b0, false, false); auto r1 = __builtin_amdgcn_permlane32_swap(a1, b1, false, false); \
        u32x4 w = {r0[0], r1[0], r0[1], r1[1]}; OUT = *reinterpret_cast<bf16x8*>(&w); } while (0)
    PK4(p0, 0, pa0); PK4(p0, 8, pa1); PK4(p1, 0, pa2); PK4(p1, 8, pa3);
#undef PK4
}
template <int KB>
__device__ __forceinline__ void qkt(f32x16& p0, f32x16& p1, const char* K_lds, int r32, int hi, const bf16x8* qr) {
    p0 = f32x16{}; p1 = f32x16{};
    const char* kb[4];
#pragma unroll
    for (int dd = 0; dd < 4; ++dd) kb[dd] = K_lds + KB * SHM_K + KSWZ(r32, (dd * 16 + hi * 8) * 2);
#pragma unroll
    for (int d0 = 0; d0 < 8; ++d0) { const char* a = kb[d0 & 3] + (d0 >> 2) * 128;
        bf16x8 b0 = *reinterpret_cast<const bf16x8*>(a);
        bf16x8 b1 = *reinterpret_cast<const bf16x8*>(a + 32 * 256);
        p0 = __builtin_amdgcn_mfma_f32_32x32x16_bf16(b0, qr[d0], p0, 0, 0, 0);
        p1 = __builtin_amdgcn_mfma_f32_32x32x16_bf16(b1, qr[d0], p1, 0, 0, 0); }
}
template <int VB>
__device__ __forceinline__ void pv_tile(f32x16* o, int vb0, bf16x8 pa0, bf16x8 pa1, bf16x8 pa2, bf16x8 pa3) {
#define TRRD(dst, off) asm volatile("ds_read_b64_tr_b16 %0, %1 offset:%2" : "=&v"(dst) : "v"(vb0), "i"(off) : "memory")
#define PV_D0(d0) do { s16x4 l0, l1, l2, l3, h0, h1, h2, h3; constexpr int b_ = VB * SHM_V + (d0) * 512; \
        TRRD(l0, b_); TRRD(h0, b_ + 4096); TRRD(l1, b_ + 8192); TRRD(h1, b_ + 12288); TRRD(l2, b_ + 16384); TRRD(h2, b_ + 20480); TRRD(l3, b_ + 24576); TRRD(h3, b_ + 28672); \
        asm volatile("s_waitcnt lgkmcnt(0)" ::: "memory"); SBAR();   \
        o[d0] = __builtin_amdgcn_mfma_f32_32x32x16_bf16(pa0, (bf16x8){l0[0], l0[1], l0[2], l0[3], h0[0], h0[1], h0[2], h0[3]}, o[d0], 0, 0, 0);   \
        o[d0] = __builtin_amdgcn_mfma_f32_32x32x16_bf16(pa1, (bf16x8){l1[0], l1[1], l1[2], l1[3], h1[0], h1[1], h1[2], h1[3]}, o[d0], 0, 0, 0);   \
        o[d0] = __builtin_amdgcn_mfma_f32_32x32x16_bf16(pa2, (bf16x8){l2[0], l2[1], l2[2], l2[3], h2[0], h2[1], h2[2], h2[3]}, o[d0], 0, 0, 0);   \
        o[d0] = __builtin_amdgcn_mfma_f32_32x32x16_bf16(pa3, (bf16x8){l3[0], l3[1], l3[2], l3[3], h3[0], h3[1], h3[2], h3[3]}, o[d0], 0, 0, 0); } while (0)
    PV_D0(0); PV_D0(1); PV_D0(2); PV_D0(3); PV_D0(4); PV_D0(5); PV_D0(6); PV_D0(7);
#undef PV_D0
#undef TRRD
}
struct BlockRef { const bf16* Q; const bf16* K; const bf16* V; bf16* O; int P0; const bf16* O1r; bf16* H; float lam; int comb; };
#define VMW() asm volatile("s_waitcnt vmcnt(0)" ::: "memory")
__device__ __forceinline__ void causal_block(const BlockRef& cur, char* lds, const int wid) {
    const int W = 1 << 30;
    const int lane = fresh_lane(), tid = wid * 64 + lane, r32 = lane & 31, hi = lane >> 5;
    const int NT = cur.P0 / KVBLK + 4;
    const int qlo = cur.P0 + wid * QBLK, qm = qlo + r32 - 4 * hi;
    char* V_lds = lds; char* K_lds = lds + 2 * SHM_V;
    float* ws = (float*)(lds + 2 * SHM_V + 2 * SHM_K) + wid * 64; float* li_l = ws, * al_l = ws + 32;
    const int vb0 = (int)(uintptr_t)V_lds + v_rd_base(lane);
    unsigned ko[2], vo[4];
#pragma unroll
    for (int i = 0; i < 2; ++i) { const int b = 16 * (tid + 512 * i), row = b >> 8, colB = (b & 255) ^ ((row & 7) << 4); ko[i] = (unsigned)(row * LDX * 2 + colB); }
#pragma unroll
    for (int i = 0; i < 4; ++i) { const int b = 16 * (tid + 512 * i), idx = b >> 9, within = b & 511, kk = (idx >> 3) * 8 + (within >> 6), c = (idx & 7) * 32 + ((within & 63) >> 1);
        const int k = (kk & ~0xC) | ((kk & 4) << 1) | ((kk & 8) >> 1); vo[i] = (unsigned)((k * LDX + c) * 2); }
    typedef __attribute__((address_space(3))) unsigned lds_u32;
#define DMA_TILE(t, bf) do { const char* kg_ = (const char*)cur.K + (size_t)(t) * (KVBLK * LDX * 2); const char* vg_ = (const char*)cur.V + (size_t)(t) * (KVBLK * LDX * 2); \
        asm volatile("" : "+s"(kg_), "+s"(vg_)); asm volatile("" : "+v"(ko[0]), "+v"(ko[1]), "+v"(vo[0]), "+v"(vo[1]), "+v"(vo[2]), "+v"(vo[3]));        \
        _Pragma("unroll") for (int i_ = 0; i_ < 2; ++i_) __builtin_amdgcn_global_load_lds((const unsigned*)(kg_ + ko[i_]), (lds_u32*)(unsigned)(uintptr_t)(K_lds + (bf) * SHM_K + i_ * 8192 + wid * 1024), 16, 0, 0); \
        _Pragma("unroll") for (int i_ = 0; i_ < 4; ++i_) __builtin_amdgcn_global_load_lds((const unsigned*)(vg_ + vo[i_]), (lds_u32*)(unsigned)(uintptr_t)(V_lds + (bf) * SHM_V + i_ * 8192 + wid * 1024), 16, 0, 0); } while (0)
    bf16x8 qr[8];
#pragma unroll
    for (int d0 = 0; d0 < 8; ++d0) qr[d0] = load8(cur.Q + (size_t)(wid * QBLK + r32) * LDX + d0 * 16 + hi * 8);
    DMA_TILE(0, 0);
    float m_reg = -1e30f, l_reg = 0; f32x16 o[8] = {};
    VMW(); __syncthreads();
#define RESC(a) do { if (__any((a) < 1.f)) { if (hi == 0) al_l[r32] = (a); asm volatile("s_waitcnt lgkmcnt(0)" ::: "memory");              \
                     for (int d_ = 0; d_ < 8; ++d_) for (int r = 0; r < 16; ++r) o[d_][r] *= al_l[crow(r, hi)]; } } while (0)
#define MASKT(P0_, P1_, t) do { const int kb_ = (t) * KVBLK; if (kb_ + KVBLK - 1 > qlo) mask_tile(P0_, P1_, qm - kb_, (unsigned)W); } while (0)
#define STEP(t, BF) do { f32x16 p0, p1; float mn, al; bf16x8 pa0, pa1, pa2, pa3;                                   \
        if ((t) + 1 < NT) DMA_TILE((t) + 1, (BF) ^ 1);                                                              \
        if ((t) * KVBLK <= qlo + QBLK - 1) {         \
        SBAR(); qkt<BF>(p0, p1, K_lds, r32, hi, qr); SBAR();                                                        \
        MASKT(p0, p1, (t)); partialSM(p0, p1, m_reg, mn, al); RESC(al);                                             \
        finishSM(p0, p1, al, l_reg, pa0, pa1, pa2, pa3); SBAR();                                                    \
        pv_tile<BF>(o, vb0, pa0, pa1, pa2, pa3); }                                                                  \
        VMW(); __syncthreads(); } while (0)
    for (int t = 0; t < NT; t += 2) { STEP(t, 0); STEP(t + 1, 1); }
    if (hi == 0) li_l[r32] = l_reg; asm volatile("s_waitcnt lgkmcnt(0)" ::: "memory");
    if (!cur.comb) {
    float rli[16];
#pragma unroll
    for (int r = 0; r < 16; ++r) rli[r] = __builtin_amdgcn_rcpf(li_l[crow(r, hi)]);
    bf16* Ow = cur.O + (size_t)(wid * QBLK) * LDX;
#pragma unroll
    for (int r = 0; r < 16; ++r) { const int orow = crow(r, hi);
#pragma unroll
        for (int d0 = 0; d0 < 8; ++d0) { const float v = o[d0][r] * rli[r];
            const float vn = __builtin_bit_cast(float, __builtin_amdgcn_update_dpp(0, __builtin_bit_cast(int, v), 0xB1, 0xf, 0xf, true));
            if ((r32 & 1) == 0) *(unsigned*)(Ow + (size_t)orow * LDX + d0 * 32 + r32) = cvtpk(v, vn); } }
    } else {
    const int ln_ = fresh_lane(), r32 = ln_ & 31, hi = ln_ >> 5;
    const bool oddl = (r32 & 1) != 0; const float lam = cur.lam;
    const char* O1u = (const char*)(cur.O1r + (size_t)(wid * QBLK) * LDX); char* Hu = (char*)(cur.H + (size_t)(wid * QBLK) * LDX);
    const unsigned lo_ = (unsigned)((4 * hi * LDX + (r32 & ~1)) * 2), so_ = (unsigned)((4 * hi * LDX + r32) * 2);
#define RC_(r) ((size_t)((((r) & 3) + 8 * ((r) >> 2)) * LDX * 2))
    unsigned wn[4][8];
#pragma unroll
    for (int i = 0; i < 4; ++i)
#pragma unroll
        for (int d0 = 0; d0 < 8; ++d0) wn[i][d0] = *(const unsigned*)(O1u + RC_(i) + d0 * 64 + (size_t)lo_);
#pragma unroll
    for (int bt = 0; bt < 4; ++bt) { unsigned wc[4][8];
#pragma unroll
        for (int i = 0; i < 4; ++i)
#pragma unroll
            for (int d0 = 0; d0 < 8; ++d0) wc[i][d0] = wn[i][d0];
        if (bt < 3) {
#pragma unroll
            for (int i = 0; i < 4; ++i)
#pragma unroll
                for (int d0 = 0; d0 < 8; ++d0) wn[i][d0] = *(const unsigned*)(O1u + RC_(4 * bt + 4 + i) + d0 * 64 + (size_t)lo_); }
        asm volatile("" ::: "memory");
        float dv[4][8];
#pragma unroll
        for (int i = 0; i < 4; ++i) { const int r = 4 * bt + i; const float rl = __builtin_amdgcn_rcpf(li_l[crow(r, hi)]); float ss = 0.f;
#pragma unroll
            for (int d0 = 0; d0 < 8; ++d0) { const float dd = (oddl ? bfhi(wc[i][d0]) : bflo(wc[i][d0])) - lam * (o[d0][r] * rl); dv[i][d0] = dd; ss += dd * dd; }
            ss += __builtin_bit_cast(float, __builtin_amdgcn_update_dpp(0, __builtin_bit_cast(int, ss), 0xB1, 0xf, 0xf, true));
            ss += __builtin_bit_cast(float, __builtin_amdgcn_update_dpp(0, __builtin_bit_cast(int, ss), 0x4E, 0xf, 0xf, true));
            ss += __builtin_bit_cast(float, __builtin_amdgcn_update_dpp(0, __builtin_bit_cast(int, ss), 0x141, 0xf, 0xf, true));
            ss += __builtin_bit_cast(float, __builtin_amdgcn_update_dpp(0, __builtin_bit_cast(int, ss), 0x140, 0xf, 0xf, true));
            ss += __builtin_bit_cast(float, __builtin_amdgcn_ds_bpermute((ln_ ^ 16) << 2, __builtin_bit_cast(int, ss)));
            const float rs = rsqrtf(ss * (1.0f / 256.0f) + NORM_EPS);
#pragma unroll
            for (int d0 = 0; d0 < 8; ++d0) dv[i][d0] *= rs; }
#pragma unroll
        for (int i = 0; i < 4; ++i) {
#pragma unroll
            for (int d0 = 0; d0 < 8; ++d0) { const float v = dv[i][d0]; const float vn = __builtin_bit_cast(float, __builtin_amdgcn_update_dpp(0, __builtin_bit_cast(int, v), 0xB1, 0xf, 0xf, true));
                if (!oddl) *(unsigned*)(Hu + RC_(4 * bt + i) + d0 * 64 + (size_t)so_) = cvtpk(v, vn); } }
        asm volatile("" ::: "memory"); }
#undef RC_
    }
    __syncthreads();
#undef RESC
#undef MASKT
#undef STEP
#undef DMA_TILE
}
#undef VMW
#undef KSWZ
#undef SBAR
__device__ __forceinline__ BlockRef make_ref(int L, int pass, int comp, const bf16* Q, const bf16* K, const bf16* V, bf16* O1, bf16* H, float lam) {
    const int xcd = L & 7, k = L >> 3, g = (k >> 2) * 8 + xcd, x = k & 3;
    const int b = g >> 3, head = g & 7, qb = pass ? 7 - x : x;
    const size_t rowb = (size_t)b * SEQ * LDX, blk = rowb + (size_t)qb * QB * LDX + head * 256;
    BlockRef R;
    R.Q = Q + blk + comp * 128;
    R.K = K + rowb + head * 256 + comp * 128;
    R.V = V + rowb + head * 256;
    R.O = O1 + blk; R.O1r = O1 + blk; R.H = H + blk; R.lam = lam; R.comb = comp;
    R.P0 = qb * QB;
    return R;
}
__device__ __forceinline__ void attn_phase(char* lds, const bf16* Q, const bf16* K, const bf16* V, bf16* O1, bf16* H, float lam, int G, int bx, const int wid) {
    constexpr int total = 512;
    for (int L = bx; L < total; L += G)
#pragma unroll 1
        for (int pc = 0; pc < 4; ++pc) { const BlockRef cur = make_ref(L, pc >> 1, pc & 1, Q, K, V, O1, H, lam); causal_block(cur, lds, wid); }
}
}

struct Args { const float* in[20]; float* out; unsigned char* ws; int ph_lo, ph_hi; };
constexpr int NPHASE = 19;

#define CAS __attribute__((address_space(4)))
__device__ __forceinline__ const CAS unsigned char* karg_base() { const CAS unsigned char* ka = (const CAS unsigned char*)__builtin_amdgcn_kernarg_segment_ptr(); asm volatile("" : "+s"(ka)); return ka; }
__device__ __forceinline__ const float* arg_in(int k) { return *(const float* const CAS*)(karg_base() + 8 * k); }
__device__ __forceinline__ float* arg_out() { return *(float* const CAS*)(karg_base() + 160); }
__device__ __forceinline__ unsigned char* arg_ws() { return *(unsigned char* const CAS*)(karg_base() + 168); }
static_assert(sizeof(Args) == 184, "Args layout");

template <bool TILED> __device__ __forceinline__ void cvt_item(const float* W, int K, int N, bf16* WT, int kb, int nb, int drow0, const float* ks, int ksmask, float scal, LAS float* scr, int lane) {
    const int k0 = kb * 64, n0 = nb * 64, q = lane >> 4, c4 = (lane & 15) * 4;
    f32x4 v[16];
#pragma unroll
    for (int i = 0; i < 16; ++i) v[i] = *(const GAS f32x4*)(W + (size_t)(k0 + 4 * i + q) * N + n0 + c4);
    const int c = lane & 7;
    f32x4 s0 = {scal, scal, scal, scal}, s1 = s0;
    if (ks) { const int kk = (k0 + 8 * c) & ksmask; s0 = *(const f32x4*)(ks + kk) * scal; s1 = *(const f32x4*)(ks + kk + 4) * scal; }
#pragma unroll
    for (int i = 0; i < 16; ++i) { LAS float* d = scr + (4 * i + q) * 65 + c4; d[0] = v[i][0]; d[1] = v[i][1]; d[2] = v[i][2]; d[3] = v[i][3]; }
    LDS_WAIT(); asm volatile("" ::: "memory");
#pragma unroll
    for (int j = 0; j < 8; ++j) { const int n = (lane >> 3) + 8 * j; const LAS float* s = scr + (8 * c) * 65 + n;
        v4u o; o.x = pk2(s[0 * 65] * s0[0], s[1 * 65] * s0[1]); o.y = pk2(s[2 * 65] * s0[2], s[3 * 65] * s0[3]); o.z = pk2(s[4 * 65] * s1[0], s[5 * 65] * s1[1]); o.w = pk2(s[6 * 65] * s1[2], s[7 * 65] * s1[3]);
        const int dr = drow0 + n;
        bf16* dst = TILED ? WT + (size_t)(dr >> 8) * 256 * K + (size_t)kb * 16384 + (dr & 255) * 64 + 8 * c : WT + (size_t)dr * K + k0 + 8 * c;
        *(GAS v4u*)dst = o; }
    LDS_WAIT(); asm volatile("" ::: "memory");
}
__device__ __forceinline__ bool cvt_matrix(int& r, const float* W, int K, int N, bf16* WT, int mode, const float* ks, int ksmask, float scal, int scal_n, LAS float* scr, int lane) {
    const int nblk = N / 64, items = (K / 64) * nblk;
    if (r >= items) { r -= items; return false; }
    const int kb = r / nblk, nb = r % nblk, n0 = nb * 64; int d0 = n0;
    if (mode == 1) { const int isup = n0 >= DFF ? 1 : 0, j = n0 - isup * DFF; d0 = (j >> 7) * 256 + isup * 128 + (j & 127); }
    else if (mode == 2 && n0 < 2048) { const int head = n0 >> 8, comp = (n0 >> 7) & 1, half = (n0 >> 6) & 1; d0 = head * 256 + half * 128 + comp * 64; }
    if (mode == 3) cvt_item<true>(W, K, N, WT, kb, nb, d0, ks, ksmask, n0 < scal_n ? scal : 1.0f, scr, lane);
    else cvt_item<false>(W, K, N, WT, kb, nb, d0, ks, ksmask, n0 < scal_n ? scal : 1.0f, scr, lane);
    return true;
}

namespace hg {
constexpr int QS_OFF = 0, KS_OFF = 8704, KH_OFF = 17408, VS_OFF = 26112, AT_OFF = 34816, DEC_OFF = 36864, RED_OFF = 37376, BUF = 38400;
constexpr int QPITCH = 272;
struct Stage { f32x4 b0, b1, l0, l1, p0, p1; v4u q, v; };
__device__ __forceinline__ void prefetch(Stage& S, const float* Bc, const bf16* Qb, const bf16* Vb, size_t off, size_t off31, size_t offp) {
    S.b0 = *(const f32x4*)(Bc + off); S.b1 = *(const f32x4*)(Bc + off + 64); S.l0 = *(const f32x4*)(Bc + off31); S.l1 = *(const f32x4*)(Bc + off31 + 64);
    S.p0 = *(const f32x4*)(Bc + offp); S.p1 = *(const f32x4*)(Bc + offp + 64);
    { const v2u qa = *(const v2u*)(Qb + off), qb = *(const v2u*)(Qb + off + 64); S.q = (v4u){qa.x, qa.y, qb.x, qb.y}; }
    { const v2u va = *(const v2u*)(Vb + off), vb = *(const v2u*)(Vb + off + 64); S.v = (v4u){va.x, va.y, vb.x, vb.y}; }
}
__device__ __forceinline__ void stage(const Stage& S, int t, int c, LAS unsigned char* B) {
    const float b[8] = {S.b0[0], S.b0[1], S.b0[2], S.b0[3], S.b1[0], S.b1[1], S.b1[2], S.b1[3]};
    const float bl[8] = {S.l0[0], S.l0[1], S.l0[2], S.l0[3], S.l1[0], S.l1[1], S.l1[2], S.l1[3]};
    const float qf[8] = {bflo(S.q.x), bfhi(S.q.x), bflo(S.q.y), bfhi(S.q.y), bflo(S.q.z), bfhi(S.q.z), bflo(S.q.w), bfhi(S.q.w)};
    const float pz = t > 0 ? 1.0f : 0.0f;
    const float bp[8] = {S.p0[0] * pz, S.p0[1] * pz, S.p0[2] * pz, S.p0[3] * pz, S.p1[0] * pz, S.p1[1] * pz, S.p1[2] * pz, S.p1[3] * pz};
    float kf[8];
#pragma unroll
    for (int j = 0; j < 8; ++j) kf[j] = 1.0f - __expf(b[j] - bp[j]);
    float qs[8], ks[8], kh[8], d[8];
#pragma unroll
    for (int j = 0; j < 8; ++j) { d[j] = __expf(bl[j]); qs[j] = qf[j] * __expf(b[j]); ks[j] = kf[j] * __expf(fminf(-b[j], 80.f)); kh[j] = kf[j] * __expf(bl[j] - b[j]); }
    LAS unsigned char* r0 = B + t * QPITCH + c * 8;
    *(LAS v2u*)(r0 + QS_OFF) = (v2u){pk2(qs[0], qs[1]), pk2(qs[2], qs[3])}; *(LAS v2u*)(r0 + QS_OFF + 128) = (v2u){pk2(qs[4], qs[5]), pk2(qs[6], qs[7])};
    *(LAS v2u*)(r0 + KS_OFF) = (v2u){pk2(ks[0], ks[1]), pk2(ks[2], ks[3])}; *(LAS v2u*)(r0 + KS_OFF + 128) = (v2u){pk2(ks[4], ks[5]), pk2(ks[6], ks[7])};
    *(LAS v2u*)(r0 + KH_OFF) = (v2u){pk2(kh[0], kh[1]), pk2(kh[2], kh[3])}; *(LAS v2u*)(r0 + KH_OFF + 128) = (v2u){pk2(kh[4], kh[5]), pk2(kh[6], kh[7])};
    *(LAS v2u*)(r0 + VS_OFF) = (v2u){S.v.x, S.v.y}; *(LAS v2u*)(r0 + VS_OFF + 128) = (v2u){S.v.z, S.v.w};
    if (t == 31) { *(LAS f32x4*)(B + DEC_OFF + c * 16) = (f32x4){d[0], d[1], d[2], d[3]}; *(LAS f32x4*)(B + DEC_OFF + 256 + c * 16) = (f32x4){d[4], d[5], d[6], d[7]}; }
}
#define HG_TR(dst, addr, off) asm volatile("ds_read_b64_tr_b16 %0, %1 offset:%2" : "=&v"(dst) : "v"(addr), "i"(off) : "memory")
__device__ __forceinline__ void scan_phase(LAS unsigned char* lds, const bf16* Qin, bf16* OUT, const float* Bc, const bf16* Vb, const bf16* SGb, int G, int vcu, const int w) {
    const int lane = fresh_lane(), tid = w * 64 + lane, l15 = lane & 15, q4 = lane >> 4;
    const int st = tid >> 4, sc = tid & 15;
    for (int unit = vcu; unit < 256; unit += G) {
        const int b = unit >> 4, h = unit & 15;
        const size_t base = (size_t)b * SEQ * DM + h * 128;
        __syncthreads();
        if (tid < 128) { const int bufi = tid >> 6, r = (tid >> 2) & 15, part = tid & 3; *(LAS u64*)(lds + bufi * BUF + AT_OFF + r * 64 + 32 + part * 8) = 0ull; }
        f32x4 S[8];
#pragma unroll
        for (int j = 0; j < 8; ++j) S[j] = (f32x4){0.f, 0.f, 0.f, 0.f};
        Stage P;
        prefetch(P, Bc, Qin, Vb, base + (size_t)st * DM + sc * 4, base + (size_t)31 * DM + sc * 4, base + (size_t)(st > 0 ? st - 1 : 0) * DM + sc * 4);
        stage(P, st, sc, lds);
        LDS_WAIT(); __syncthreads();
        for (int c = 0; c < 64; ++c) {
            LAS unsigned char* B = lds + (c & 1) * BUF;
            const size_t crow0 = base + (size_t)c * 32 * DM;
            if (c + 1 < 64) prefetch(P, Bc, Qin, Vb, crow0 + (size_t)(32 + st) * DM + sc * 4, crow0 + (size_t)63 * DM + sc * 4, crow0 + (size_t)(32 + (st > 0 ? st - 1 : 0)) * DM + sc * 4);
            const v2u sg0 = *(const v2u*)(SGb + crow0 + (size_t)l15 * DM + 16 * w + 4 * q4);
            const v2u sg1 = *(const v2u*)(SGb + crow0 + (size_t)(l15 + 16) * DM + 16 * w + 4 * q4);
            if (w < 3) { const int tt = w > 0 ? 1 : 0, stl = w > 1 ? 1 : 0; f32x4 a = {0.f, 0.f, 0.f, 0.f};
#pragma unroll
                for (int j = 0; j < 4; ++j) { const bf16x8 qa = *(const LAS bf16x8*)(B + QS_OFF + (16 * tt + l15) * QPITCH + (32 * j + 8 * q4) * 2);
                    const bf16x8 kb = *(const LAS bf16x8*)(B + KS_OFF + (16 * stl + l15) * QPITCH + (32 * j + 8 * q4) * 2);
                    a = __builtin_amdgcn_mfma_f32_16x16x32_bf16(qa, kb, a, 0, 0, 0); }
#pragma unroll
                for (int i = 0; i < 4; ++i) { const int t = 16 * tt + 4 * q4 + i, s_ = 16 * stl + l15; const float v = s_ <= t ? a[i] : 0.f;
                    *(LAS unsigned short*)(B + AT_OFF + t * 64 + s_ * 2) = (unsigned short)pk2(v, 0.f); } }
            f32x4 o0 = {0.f, 0.f, 0.f, 0.f}, o1 = {0.f, 0.f, 0.f, 0.f};
#pragma unroll
            for (int j = 0; j < 4; ++j) { v4u sw; sw.x = pk2(S[2 * j][0], S[2 * j][1]); sw.y = pk2(S[2 * j][2], S[2 * j][3]); sw.z = pk2(S[2 * j + 1][0], S[2 * j + 1][1]); sw.w = pk2(S[2 * j + 1][2], S[2 * j + 1][3]);
                const bf16x8 sa = __builtin_bit_cast(bf16x8, sw);
                const LAS unsigned char* qp = B + QS_OFF + l15 * QPITCH + (32 * j + 4 * q4) * 2;
                const v2u a0 = *(const LAS v2u*)qp, a1 = *(const LAS v2u*)(qp + 32), c0 = *(const LAS v2u*)(qp + 16 * QPITCH), c1 = *(const LAS v2u*)(qp + 16 * QPITCH + 32);
                const v4u f0 = {a0.x, a0.y, a1.x, a1.y}, f1 = {c0.x, c0.y, c1.x, c1.y};
                o0 = __builtin_amdgcn_mfma_f32_16x16x32_bf16(sa, __builtin_bit_cast(bf16x8, f0), o0, 0, 0, 0);
                o1 = __builtin_amdgcn_mfma_f32_16x16x32_bf16(sa, __builtin_bit_cast(bf16x8, f1), o1, 0, 0, 0); }
            const unsigned trb = (unsigned)(uintptr_t)B + (8 * q4 + (l15 >> 2)) * QPITCH + (l15 & 3) * 8;
            s16x4 vlo, vhi;
            HG_TR(vlo, trb + VS_OFF + 32 * w, 0); HG_TR(vhi, trb + VS_OFF + 32 * w, 4 * QPITCH);
            LDS_WAIT(); __syncthreads(); __builtin_amdgcn_sched_barrier(0);
            const bf16x8 vt = (bf16x8){vlo[0], vlo[1], vlo[2], vlo[3], vhi[0], vhi[1], vhi[2], vhi[3]};
            { const bf16x8 at0 = *(const LAS bf16x8*)(B + AT_OFF + l15 * 64 + q4 * 16), at1 = *(const LAS bf16x8*)(B + AT_OFF + (l15 + 16) * 64 + q4 * 16);
              o0 = __builtin_amdgcn_mfma_f32_16x16x32_bf16(vt, at0, o0, 0, 0, 0);
              o1 = __builtin_amdgcn_mfma_f32_16x16x32_bf16(vt, at1, o1, 0, 0, 0); }
            { float p0 = (o0[0] * o0[0] + o0[1] * o0[1]) + (o0[2] * o0[2] + o0[3] * o0[3]), p1 = (o1[0] * o1[0] + o1[1] * o1[1]) + (o1[2] * o1[2] + o1[3] * o1[3]);
              p0 += __shfl_xor(p0, 16); p0 += __shfl_xor(p0, 32); p1 += __shfl_xor(p1, 16); p1 += __shfl_xor(p1, 32);
              if (q4 == 0) { *(LAS float*)(B + RED_OFF + (w * 32 + l15) * 4) = p0; *(LAS float*)(B + RED_OFF + (w * 32 + 16 + l15) * 4) = p1; } }
#pragma unroll
            for (int jp = 0; jp < 4; ++jp) { s16x4 a0, a1, c0, c1;
                HG_TR(a0, trb + KH_OFF, (2 * jp) * 32); HG_TR(a1, trb + KH_OFF, (2 * jp) * 32 + 4 * QPITCH); HG_TR(c0, trb + KH_OFF, (2 * jp + 1) * 32); HG_TR(c1, trb + KH_OFF, (2 * jp + 1) * 32 + 4 * QPITCH);
                const f32x4 d0 = *(const LAS f32x4*)(B + DEC_OFF + (16 * (2 * jp) + 4 * q4) * 4), d1 = *(const LAS f32x4*)(B + DEC_OFF + (16 * (2 * jp + 1) + 4 * q4) * 4);
                LDS_WAIT(); __builtin_amdgcn_sched_barrier(0);
                S[2 * jp] = __builtin_amdgcn_mfma_f32_16x16x32_bf16((bf16x8){a0[0], a0[1], a0[2], a0[3], a1[0], a1[1], a1[2], a1[3]}, vt, S[2 * jp] * d0, 0, 0, 0);
                S[2 * jp + 1] = __builtin_amdgcn_mfma_f32_16x16x32_bf16((bf16x8){c0[0], c0[1], c0[2], c0[3], c1[0], c1[1], c1[2], c1[3]}, vt, S[2 * jp + 1] * d1, 0, 0, 0); }
            if (c + 1 < 64) stage(P, st, sc, lds + ((c + 1) & 1) * BUF);
            LDS_WAIT(); __syncthreads();
            float s0 = 0.f, s1 = 0.f;
#pragma unroll
            for (int ww = 0; ww < 8; ++ww) { s0 += *(const LAS float*)(B + RED_OFF + (ww * 32 + l15) * 4); s1 += *(const LAS float*)(B + RED_OFF + (ww * 32 + 16 + l15) * 4); }
            const float r0 = rsqrtf(s0 * (1.0f / 128.0f) + NORM_EPS), r1 = rsqrtf(s1 * (1.0f / 128.0f) + NORM_EPS);
            v2u w0, w1;
            w0.x = pk2(o0[0] * r0 * bflo(sg0.x), o0[1] * r0 * bfhi(sg0.x)); w0.y = pk2(o0[2] * r0 * bflo(sg0.y), o0[3] * r0 * bfhi(sg0.y));
            w1.x = pk2(o1[0] * r1 * bflo(sg1.x), o1[1] * r1 * bfhi(sg1.x)); w1.y = pk2(o1[2] * r1 * bflo(sg1.y), o1[3] * r1 * bfhi(sg1.y));
            *(v2u*)(OUT + crow0 + (size_t)l15 * DM + 16 * w + 4 * q4) = w0;
            *(v2u*)(OUT + crow0 + (size_t)(l15 + 16) * DM + 16 * w + 4 * q4) = w1;
        }
    }
}
#undef HG_TR
}

__global__ void __launch_bounds__(NWAVES * 64, 2) yoco_fwd(Args args) {
    extern __shared__ __attribute__((aligned(16))) unsigned char lds_raw[];
    LAS unsigned char* lds = (LAS unsigned char*)lds_raw;
    volatile LAS unsigned* MISC = (volatile LAS unsigned*)(lds + MISC_OFF);
    const int wave = __builtin_amdgcn_readfirstlane((int)threadIdx.x >> 6);
    const int G = gridDim.x, bx = blockIdx.x, vcu = (G % 8 == 0) ? (bx % 8) * (G / 8) + bx / 8 : bx;
    for (int u = wave * 64 + fresh_lane(); u < (LDS_BYTES - LDSCTL_OFF) / 4; u += NWAVES * 64) ((LAS unsigned*)(lds + LDSCTL_OFF))[u] = 0u;
    __syncthreads();
    XcdBarrier bar; bar.bar = (unsigned*)(arg_ws() + WS_CTL) + CW_BAR; bar.x = 0; bar.st = nullptr;
    if (MK_N_LAUNCHES == 1) bar = xcd_barrier_post((unsigned*)(arg_ws() + WS_CTL) + CW_BAR, MISC + 8, wave);
#define GRID_BAR() do { if (MK_N_LAUNCHES == 1) xcd_barrier(bar, wave); } while (0)
    const int lo = args.ph_lo, hi = args.ph_hi;
#define IN(k) (lo <= (k) && (k) < hi)
#define BOTH(k) (IN(k) && IN((k) + 1))
#define STAT(i) ((float*)(ws + WS_STATS) + (size_t)(i) * 8 * MTOK)
#define REDP ((LAS float*)(lds + RED_OFF))
#define WPTR(off) ((bf16*)(ws + WS_W + (off)))
#define BIGP(T, off) ((T*)(ws + WS_BIG + (off)))
#define HB1P ((bf16*)(ws + WS_HB1))
#define HB2P ((bf16*)(ws + WS_HB2))
#define ROPE_COS ((float*)(ws + WS_TAB))
#define ROPE_SIN ((float*)(ws + WS_TAB + 512 * 1024))
#define LBTAB ((float*)(ws + WS_TAB + MiB))
#define LAMP ((float*)(ws + WS_TAB + MiB + 16384))
#define FNTAB ((float*)(ws + WS_TAB + MiB + 32768))

    if (IN(0)) {
        for (int rep_ = 0; rep_ < (PROBE_DUP == 0 ? 2 : 1); ++rep_) {
        unsigned char* ws = arg_ws();
        const int lane = fresh_lane(), tid = wave * 64 + lane;
        LAS float* scr = (LAS float*)(lds + RING_OFF + wave * 16640);
        const int gw = vcu * NWAVES + wave, NGW = G * NWAVES;
        constexpr int ITEMS = (4 * DM * NGU + 4 * DFF * DM + DM * 8192 + 5 * DM * DM + DM * 4096 + 2 * 256 * DM) / 4096;
        for (int it = gw; it < ITEMS; it += NGW) {
            int r = it; bool done = false;
#pragma unroll 1
            for (int f = 0; f < 4 && !done; ++f) done = cvt_matrix(r, arg_in(3) + (size_t)f * DM * NGU, DM, NGU, WPTR(W_GU + (size_t)f * 44 * MiB), 1, arg_in(2) + f * DM, DM - 1, 1.0f, 0, scr, lane);
#pragma unroll 1
            for (int f = 0; f < 4 && !done; ++f) done = cvt_matrix(r, arg_in(4) + (size_t)f * DFF * DM, DFF, DM, WPTR(W_DN + (size_t)f * 22 * MiB), 3, nullptr, 0, 1.0f, 0, scr, lane);
            if (!done) done = cvt_matrix(r, arg_in(6), DM, 8192, WPTR(W_HIN), 0, arg_in(5), DM - 1, QSCALE, 2048, scr, lane);
            if (!done) done = cvt_matrix(r, arg_in(9), DM, DM, WPTR(W_HOUT), 0, arg_in(8), 127, 1.0f, 0, scr, lane);
            if (!done) done = cvt_matrix(r, arg_in(11), DM, 4096, WPTR(W_KV), 2, arg_in(10), DM - 1, 1.0f, 0, scr, lane);
            if (!done) done = cvt_matrix(r, arg_in(12), DM, DM, WPTR(W_Q), 2, arg_in(5) + DM, DM - 1, 1.0f, 0, scr, lane);
            if (!done) done = cvt_matrix(r, arg_in(15), DM, DM, WPTR(W_AO), 0, arg_in(14), 255, 1.0f - LAMBDA_INIT, DM, scr, lane);
#pragma unroll 1
            for (int f = 0; f < 2 && !done; ++f) done = cvt_matrix(r, arg_in(17) + (size_t)f * DM * DM, DM, DM, WPTR(W_PG + (size_t)f * 8 * MiB), 0, arg_in(16) + f * DM, DM - 1, 1.0f, 0, scr, lane);
#pragma unroll 1
            for (int f = 0; f < 2 && !done; ++f) done = cvt_matrix(r, arg_in(18) + (size_t)f * 256 * DM, 256, DM, WPTR(W_PP + (size_t)f * MiB), 0, nullptr, 0, 1.0f, 0, scr, lane);
        }
        { const float* x = arg_in(0); bf16* HB1 = HB1P; float* st0 = STAT(0);
          for (int m = gw; m < MTOK; m += NGW) {
            const GAS f32x4* xr = (const GAS f32x4*)(x + (size_t)m * DM) + lane; GAS v2u* o8 = (GAS v2u*)(HB1 + (size_t)m * DM) + lane; float s = 0.f;
#pragma unroll
            for (int j = 0; j < 8; ++j) { const f32x4 v = xr[64 * j]; s += (v[0] * v[0] + v[1] * v[1]) + (v[2] * v[2] + v[3] * v[3]); v2u o; o.x = pk2(v[0], v[1]); o.y = pk2(v[2], v[3]); o8[64 * j] = o; }
            s = wave_sum(s);
            if (lane < 8) st0[(size_t)lane * MTOK + m] = lane == 0 ? s : 0.f;
          } }
        { const float* pin = arg_in(1); bf16* PB = (bf16*)(ws + WS_PB); const size_t n8 = (size_t)2 * MTOK * 256 / 8;
          for (size_t i = (size_t)bx * 512 + tid; i < n8; i += (size_t)G * 512) { const f32x4 a = *(const f32x4*)(pin + i * 8), b = *(const f32x4*)(pin + i * 8 + 4);
              v4u o; o.x = pk2(a[0], a[1]); o.y = pk2(a[2], a[3]); o.z = pk2(b[0], b[1]); o.w = pk2(b[2], b[3]); *(v4u*)(PB + i * 8) = o; } }
        { float* rope_cos = ROPE_COS; float* rope_sin = ROPE_SIN;
          for (int e = bx * 512 + tid; e < SEQ * 64; e += G * 512) {
            const int pos = e >> 6, i = e & 63;
            double f = 1.0; for (int k = 0; k < i; ++k) f *= 0.8659643233600653;
            const float ang = (float)pos * (float)f;
            const double a = (double)ang; const double kq = __builtin_rint(a * 0.63661977236758134); const double rr = (a - kq * 1.5707963267948966) - kq * 6.123233995736766e-17;
            const double r2 = rr * rr;
            double sp = 1.0 / 6227020800.0; sp = sp * r2 - 1.0 / 39916800.0; sp = sp * r2 + 1.0 / 362880.0; sp = sp * r2 - 1.0 / 5040.0; sp = sp * r2 + 1.0 / 120.0; sp = sp * r2 - 1.0 / 6.0; sp = sp * r2 + 1.0; sp *= rr;
            double cp = 1.0 / 87178291200.0; cp = -cp * r2 + 1.0 / 479001600.0; cp = cp * r2 - 1.0 / 3628800.0; cp = cp * r2 + 1.0 / 40320.0; cp = cp * r2 - 1.0 / 720.0; cp = cp * r2 + 1.0 / 24.0; cp = cp * r2 - 0.5; cp = cp * r2 + 1.0;
            const int qd = ((int)kq) & 3;
            const double sv = qd == 0 ? sp : (qd == 1 ? cp : (qd == 2 ? -sp : -cp)), cv = qd == 0 ? cp : (qd == 1 ? -sp : (qd == 2 ? -cp : sp));
            rope_cos[e] = (float)cv; rope_sin[e] = (float)sv;
          } }
        { const float* lbin = arg_in(7); const float* fn = arg_in(19); float* lbtab = LBTAB; float* fnt = FNTAB;
          for (int e = bx * 512 + tid; e < DM; e += G * 512) { const float a0 = lbin[e], a1 = lbin[DM + e]; lbtab[e] = 1.0f / (1.0f + expf(a1 - a0)); fnt[e] = fn[e]; } }
        if (bx == 0 && wave == 0) { const float* lam = arg_in(13); float d1 = lam[lane] * lam[128 + lane] + lam[64 + lane] * lam[192 + lane], d2 = lam[256 + lane] * lam[384 + lane] + lam[320 + lane] * lam[448 + lane];
            d1 = wave_sum(d1); d2 = wave_sum(d2); if (lane == 0) LAMP[0] = expf(d1) - expf(d2) + LAMBDA_INIT; }
        }
        if (BOTH(0)) GRID_BAR();
    }

#define RSTAB ((const LAS float*)(lds + RSTAB_OFF))
#define FILL_RSTD(i) fill_rstd_table((LAS float*)(lds + RSTAB_OFF), STAT(i), bx, wave)
#define GEMM_PHASE_T(EpiT, Eobj, Aptr, Bptr, Nn, Kk) do { pg8::Gemm g_{(const bf16*)(Aptr), (const bf16*)(Bptr), MTOK, (Nn), (Kk)}; pg8::StaticOrder S_; S_.init(MTOK, (Nn), G, bx); \
        pg8::gemm_phase<EpiT, pg8::StaticOrder, true, true, true, true>(lds + RING_OFF, g_, S_, Eobj, wave); } while (0)
#define GEMM_PHASE(EpiT, Eobj, Aptr, Bptr, Nn, Kk) do { pg8::Gemm g_{(const bf16*)(Aptr), (const bf16*)(Bptr), MTOK, (Nn), (Kk)}; pg8::StaticOrder S_; S_.init(MTOK, (Nn), G, bx); \
        pg8::gemm_phase<EpiT, pg8::StaticOrder, true, true>(lds + RING_OFF, g_, S_, Eobj, wave); } while (0)

    if (IN(1)) { unsigned char* ws = arg_ws(); FILL_RSTD(0); EpiGU E{BIGP(bf16, BIG_HID), RSTAB}; if (PROBE_DUP == 1) GEMM_PHASE(EpiGU, E, HB1P, WPTR(W_GU + 0 * 44 * MiB), NGU, DM); GEMM_PHASE(EpiGU, E, HB1P, WPTR(W_GU + 0 * 44 * MiB), NGU, DM); if (PROBE_DUP == 100) { for (int rep_ = 0; rep_ < 20; ++rep_) GRID_BAR(); } if (BOTH(1)) GRID_BAR(); }
    if (IN(2)) { unsigned char* ws = arg_ws(); EpiRes<true> E{arg_in(0), HB1P, STAT(1), 0.5f, REDP}; GEMM_PHASE_T(EpiRes<true>, E, BIGP(bf16, BIG_HID), WPTR(W_DN + 0 * 22 * MiB), DM, DFF);
        if (BOTH(2)) GRID_BAR(); }
    if (IN(3)) { unsigned char* ws = arg_ws(); FILL_RSTD(1); EpiHgIn E{BIGP(bf16, BIG_HQ), BIGP(float, BIG_HLF), BIGP(bf16, BIG_HV), BIGP(bf16, BIG_HSG), RSTAB, LBTAB};
        if (PROBE_DUP == 3) GEMM_PHASE(EpiHgIn, E, HB1P, WPTR(W_HIN), 8192, DM);
        GEMM_PHASE(EpiHgIn, E, HB1P, WPTR(W_HIN), 8192, DM); if (BOTH(3)) GRID_BAR(); }
    if (IN(4)) { unsigned char* ws = arg_ws();
        hg::scan_phase(lds + RING_OFF, BIGP(const bf16, BIG_HQ), BIGP(bf16, BIG_HQ), BIGP(const float, BIG_HLF), BIGP(const bf16, BIG_HV), BIGP(const bf16, BIG_HSG), G, vcu, wave); if (BOTH(4)) GRID_BAR(); }
    if (IN(5)) { unsigned char* ws = arg_ws(); EpiRes<false> E{HB1P, HB1P, STAT(2), 1.0f, REDP}; GEMM_PHASE(EpiRes<false>, E, BIGP(bf16, BIG_HQ), WPTR(W_HOUT), DM, DM); if (BOTH(5)) GRID_BAR(); }
    if (IN(6)) { unsigned char* ws = arg_ws(); FILL_RSTD(2); EpiGU E{BIGP(bf16, BIG_HID), RSTAB}; GEMM_PHASE(EpiGU, E, HB1P, WPTR(W_GU + 1 * 44 * MiB), NGU, DM); if (BOTH(6)) GRID_BAR(); }
    if (IN(7)) { unsigned char* ws = arg_ws();
                 { EpiRes<false> E{HB1P, HB1P, STAT(3), 0.5f, REDP}; GEMM_PHASE_T(EpiRes<false>, E, BIGP(bf16, BIG_HID), WPTR(W_DN + 1 * 22 * MiB), DM, DFF); }
                 { EpiPlain E{BIGP(bf16, BIG_PP)}; GEMM_PHASE(EpiPlain, E, ws + WS_PB, WPTR(W_PP), DM, 256); }
                 if (BOTH(7)) GRID_BAR(); }
    if (IN(8)) { unsigned char* ws = arg_ws(); FILL_RSTD(3); EpiPleG E{HB1P, HB2P, STAT(4), RSTAB, BIGP(const bf16, BIG_PP), REDP}; GEMM_PHASE(EpiPleG, E, HB1P, WPTR(W_PG), DM, DM); if (BOTH(8)) GRID_BAR(); }
    if (IN(9)) { unsigned char* ws = arg_ws();
                 FILL_RSTD(4);
                 { EpiRope E{BIGP(bf16, BIG_KR), BIGP(bf16, BIG_VV), 8, RSTAB, ROPE_COS, ROPE_SIN}; if (PROBE_DUP == 9) GEMM_PHASE(EpiRope, E, HB2P, WPTR(W_KV), 4096, DM); GEMM_PHASE(EpiRope, E, HB2P, WPTR(W_KV), 4096, DM); }
                 { EpiGU E{BIGP(bf16, BIG_HID), RSTAB}; GEMM_PHASE(EpiGU, E, HB2P, WPTR(W_GU + 2 * 44 * MiB), NGU, DM); }
                 if (BOTH(9)) GRID_BAR(); }
    if (IN(10)) { unsigned char* ws = arg_ws(); EpiRes<false> E{HB2P, HB1P, STAT(5), 0.5f, REDP}; GEMM_PHASE_T(EpiRes<false>, E, BIGP(bf16, BIG_HID), WPTR(W_DN + 2 * 22 * MiB), DM, DFF); if (BOTH(10)) GRID_BAR(); }
    if (IN(11)) { unsigned char* ws = arg_ws(); FILL_RSTD(5); EpiRope E{BIGP(bf16, BIG_QR), BIGP(bf16, BIG_QR), 8, RSTAB, ROPE_COS, ROPE_SIN}; if (PROBE_DUP == 11) GEMM_PHASE(EpiRope, E, HB1P, WPTR(W_Q), DM, DM); GEMM_PHASE(EpiRope, E, HB1P, WPTR(W_Q), DM, DM); if (BOTH(11)) GRID_BAR(); }
    if (IN(12)) { unsigned char* ws = arg_ws();
                  att::attn_phase((char*)lds_raw + RING_OFF, BIGP(const bf16, BIG_QR), BIGP(const bf16, BIG_KR), BIGP(const bf16, BIG_VV), BIGP(bf16, BIG_O1), HB2P, LAMP[0], G, bx, wave);
                  if (BOTH(12)) GRID_BAR(); }
    if (IN(13)) { }
    if (IN(14)) { unsigned char* ws = arg_ws(); EpiRes<false> E{HB1P, HB1P, STAT(6), 1.0f, REDP}; GEMM_PHASE(EpiRes<false>, E, HB2P, WPTR(W_AO), DM, DM); if (BOTH(14)) GRID_BAR(); }
    if (IN(15)) { unsigned char* ws = arg_ws(); FILL_RSTD(6); EpiGU E{BIGP(bf16, BIG_HID), RSTAB}; GEMM_PHASE(EpiGU, E, HB1P, WPTR(W_GU + 3 * 44 * MiB), NGU, DM); if (BOTH(15)) GRID_BAR(); }
    if (IN(16)) { unsigned char* ws = arg_ws();
                  { EpiRes<false> E{HB1P, HB1P, STAT(7), 0.5f, REDP}; GEMM_PHASE_T(EpiRes<false>, E, BIGP(bf16, BIG_HID), WPTR(W_DN + 3 * 22 * MiB), DM, DFF); }
                  { EpiPlain E{BIGP(bf16, BIG_PP)}; GEMM_PHASE(EpiPlain, E, ws + WS_PB + (size_t)MTOK * 256 * 2, WPTR(W_PP + MiB), DM, 256); }
                  if (BOTH(16)) GRID_BAR(); }
    if (IN(17)) { unsigned char* ws = arg_ws(); FILL_RSTD(7); EpiPleG E{HB1P, HB2P, STAT(8), RSTAB, BIGP(const bf16, BIG_PP), REDP}; GEMM_PHASE(EpiPleG, E, HB1P, WPTR(W_PG + 8 * MiB), DM, DM); if (BOTH(17)) GRID_BAR(); }
    if (IN(18)) {
        unsigned char* ws = arg_ws(); float* out = arg_out(); const bf16* HB2 = HB2P;
        const int lane = fresh_lane();
        const float* gn = FNTAB; const int gw = vcu * NWAVES + wave, NGW = G * NWAVES;
        unsigned poison = 0;
        if (MK_N_LAUNCHES == 1) poison = __hip_atomic_load((unsigned*)(ws + WS_CTL) + CW_BAR + XB_TMO, RLX_AGENT);
        const float* st8 = STAT(8);
        for (int m = gw; m < MTOK; m += NGW) { const float rs = poison ? __builtin_nanf("") : stat_rstd(st8, m);
#pragma unroll
            for (int j = 0; j < 4; ++j) { const int c = lane * 8 + 512 * j; const v4u r = *(const v4u*)(HB2 + (size_t)m * DM + c);
                const f32x4 g0 = *(const f32x4*)(gn + c), g1 = *(const f32x4*)(gn + c + 4);
                const f32x4 o0 = {bflo(r.x) * rs * g0[0], bfhi(r.x) * rs * g0[1], bflo(r.y) * rs * g0[2], bfhi(r.y) * rs * g0[3]};
                const f32x4 o1 = {bflo(r.z) * rs * g1[0], bfhi(r.z) * rs * g1[1], bflo(r.w) * rs * g1[2], bfhi(r.w) * rs * g1[3]};
                *(f32x4*)(out + (size_t)m * DM + c) = o0; *(f32x4*)(out + (size_t)m * DM + c + 4) = o1; } }
    }
#undef IN
#undef BOTH
}

extern "C" void kernel_launch(void* const* d_in, const int* in_sizes, int n_in, void* d_out, int out_size, void* d_ws, size_t ws_size, hipStream_t stream) {
    static int grid = 0;
    if (grid == 0) {
        if (n_in != 20 || in_sizes[0] != MTOK * DM || out_size != MTOK * DM || ws_size < WS_END) { fprintf(stderr, "kernel_launch: unexpected shapes (n_in %d, in0 %d, out %d, ws %zu < %zu)\n", n_in, n_in > 0 ? in_sizes[0] : -1, out_size, ws_size, (size_t)WS_END); grid = -1; return; }
        int dev = 0, cus = 0, per_cu = 0;
        if (hipGetDevice(&dev) != hipSuccess || hipDeviceGetAttribute(&cus, hipDeviceAttributeMultiprocessorCount, dev) != hipSuccess) { grid = -1; return; }
        if (hipFuncSetAttribute((const void*)yoco_fwd, hipFuncAttributeMaxDynamicSharedMemorySize, LDS_BYTES) != hipSuccess) { fprintf(stderr, "kernel_launch: hipFuncSetAttribute failed\n"); grid = -1; return; }
        if (hipOccupancyMaxActiveBlocksPerMultiprocessor(&per_cu, (const void*)yoco_fwd, NWAVES * 64, LDS_BYTES) != hipSuccess || per_cu < 1) fprintf(stderr, "kernel_launch: occupancy query says %d\n", per_cu);
        (void)hipGetLastError();
        grid = cus > 256 ? 256 : (cus / 8) * 8;
        if (grid < 8) { fprintf(stderr, "kernel_launch: device has %d CUs; at least 8 are needed\n", cus); grid = -1; return; }
    }
    if (grid < 0) return;
    (void)hipMemsetAsync((char*)d_ws + WS_CTL, 0, CTL_ZERO_BYTES, stream);
    Args a{};
    for (int i = 0; i < 20; ++i) a.in[i] = (const float*)d_in[i];
    a.out = (float*)d_out; a.ws = (unsigned char*)d_ws;
#if MK_N_LAUNCHES == 1
    a.ph_lo = 0; a.ph_hi = NPHASE;
    hipLaunchKernelGGL(yoco_fwd, dim3(grid), dim3(NWAVES * 64), LDS_BYTES, stream, a);
#else
    for (int k = 0; k < NPHASE; ++k) { a.ph_lo = k; a.ph_hi = k + 1; hipLaunchKernelGGL(yoco_fwd, dim3(grid), dim3(NWAVES * 64), LDS_BYTES, stream, a); }
#endif
}
```

```cpp
#include <hip/hip_runtime.h>
#include <hip/hip_bf16.h>
#include <cstdio>
#include <cstdint>

#ifndef PROBE_DUP
#define PROBE_DUP -1
#endif
#ifndef MK_N_LAUNCHES
#define MK_N_LAUNCHES 1
#endif

__device__ __forceinline__ int fresh_lane() { int l; asm volatile("v_mbcnt_lo_u32_b32 %0, -1, 0\n\tv_mbcnt_hi_u32_b32 %0, -1, %0" : "=v"(l)); return l; }
namespace pg8 {
#define PG8_LAS __attribute__((address_space(3)))
typedef unsigned short bf16_t;
typedef short bf16x8 __attribute__((ext_vector_type(8)));
typedef float f32x4 __attribute__((ext_vector_type(4)));
typedef unsigned u32x4 __attribute__((ext_vector_type(4)));
constexpr int BM = 256, BK = 64, HALF = 128, HTB = HALF * BK * 2, STAGE_BYTES = 8 * HTB, NXCD = 8, WGM = 4;

__host__ __device__ __forceinline__ int lds_byte(int r, int c) { const int st = (r >> 4) * 2 + (c >> 5), rr = r & 15, cc = c & 31, ob = rr * 64 + cc * 2; return st * 1024 + (ob ^ (((ob >> 9) & 1) << 5)); }
__host__ __device__ __forceinline__ void stage_rc(int b, int& R, int& C) { const int st = b / 1024, sb = b % 1024, swz = sb ^ (((sb >> 9) & 1) << 5); R = (st >> 1) * 16 + swz / 64; C = (st & 1) * 32 + (swz % 64) / 2; }
__host__ __device__ __forceinline__ int perm32(int rho) { const int n = rho >> 4, i = rho & 15; return 8 * (i >> 2) + 4 * n + (i & 3); }

struct Unit { int pm, pn; };
struct Gemm { const bf16_t* A; const bf16_t* Bt; int M, N, K; };

struct StaticOrder {
    int nM, nN, nwg, G, c;
    __host__ __device__ void init(int M, int N, int G_, int c_) { nM = M / BM; nN = N / BM; nwg = nM * nN; G = G_; c = c_; }
    __host__ __device__ bool next(int i, Unit& u) const {
        const long L = (long)i * G + c; if (L >= nwg) return false;
        int wgid = (int)L; { const int q = nwg / NXCD, r = nwg % NXCD, xcd = wgid % NXCD, off = wgid / NXCD; wgid = (xcd < r ? xcd * (q + 1) : r * (q + 1) + (xcd - r) * q) + off; }
        const int nig = WGM * nN, gid = wgid / nig, fm = gid * WGM, gsz = (nM - fm) < WGM ? (nM - fm) : WGM;
        u.pm = fm + ((wgid % nig) % gsz); u.pn = (wgid % nig) / gsz; return true;
    }
    __device__ __forceinline__ void a_ready(const Unit&) const {}
    __device__ __forceinline__ void done(const Unit&) const {}
};

template <class Epi, class Sched, bool ALIGN_EPI, bool SP2, bool ATILED = false, bool BTILED = false>
__device__ __forceinline__ void gemm_phase(PG8_LAS unsigned char* lds, const Gemm g, const Sched& S, const Epi& E, const int wid) {
    const int lane = fresh_lane(), tid = wid * 64 + lane, wr = wid >> 2, wc = wid & 3, fr = lane & 15, fq = lane >> 4;
    const int K = g.K, nt = K / BK;
    unsigned voffA[2], voffB[2];
#pragma unroll
    for (int i = 0; i < 2; ++i) { int R, C; stage_rc(tid * 16 + i * 8192, R, C); const int Rb = Epi::PERM ? ((R & ~31) + perm32(R & 31)) : R;
        voffA[i] = (unsigned)(R * (ATILED ? BK : K) + C) * 2u; voffB[i] = (unsigned)(Rb * (BTILED ? BK : K) + C) * 2u; }
    const size_t kstepA = ATILED ? (size_t)(BM * BK * 2) : (size_t)(BK * 2), kstepB = BTILED ? (size_t)(BM * BK * 2) : (size_t)(BK * 2);
    const size_t hstepA = ATILED ? (size_t)(HALF * BK * 2) : (size_t)HALF * K * 2, hstepB = BTILED ? (size_t)(HALF * BK * 2) : (size_t)HALF * K * 2;
    const size_t tstep = (size_t)BM * K * 2;
    const unsigned ldsw = (unsigned)wid * 1024u;
    const int aoff = lds_byte(wr * 64 + fr, fq * 8), boff = lds_byte(wc * 32 + fr, fq * 8);
#define PG8_SA(b, h) (((b) * 2 + (h)) * HTB)
#define PG8_SB(b, h) ((4 + (b) * 2 + (h)) * HTB)
#define PG8_STAGE(bufoff, gbase, voff) do { const char* gb_ = (const char*)(gbase); asm volatile("" : "+s"(gb_));        \
        _Pragma("unroll") for (int _i = 0; _i < 2; ++_i) \
        __builtin_amdgcn_global_load_lds((const unsigned*)(gb_ + (voff)[_i]), (PG8_LAS unsigned*)(lds + (bufoff) + ldsw + _i * 8192), 16, 0, 0); } while (0)
#define PG8_LDA(dst, b, h) do { _Pragma("unroll") for (int m = 0; m < 4; ++m) _Pragma("unroll") for (int k = 0; k < 2; ++k) dst[m][k] = *(const PG8_LAS bf16x8*)(lds + PG8_SA(b, h) + aoff + m * 2048 + k * 1024); } while (0)
#define PG8_LDB(dst, b, h) do { _Pragma("unroll") for (int n = 0; n < 2; ++n) _Pragma("unroll") for (int k = 0; k < 2; ++k) dst[n][k] = *(const PG8_LAS bf16x8*)(lds + PG8_SB(b, h) + boff + n * 2048 + k * 1024); } while (0)
#define PG8_MMA(ai, bj, At, Bt) do { __builtin_amdgcn_s_setprio(1); _Pragma("unroll") for (int m = 0; m < 4; ++m) _Pragma("unroll") for (int n = 0; n < 2; ++n) _Pragma("unroll") for (int k = 0; k < 2; ++k) \
        acc[ai][bj][m][n] = __builtin_amdgcn_mfma_f32_16x16x32_bf16(Bt[n][k], At[m][k], acc[ai][bj][m][n], 0, 0, 0); __builtin_amdgcn_s_setprio(0); } while (0)
#define PG8_WAIT_V(n) asm volatile("s_waitcnt vmcnt(" #n ")" ::: "memory")
#define PG8_WAIT_L(n) asm volatile("s_waitcnt lgkmcnt(" #n ")" ::: "memory")
#define PG8_BAR __builtin_amdgcn_s_barrier()
#define PG8_SCHED __builtin_amdgcn_sched_barrier(0)
    Unit cur, nxt; int ui = 0;
    if (!S.next(0, cur)) return;
    f32x4 acc[2][2][4][2];
#pragma unroll
    for (int a = 0; a < 2; ++a)
#pragma unroll
        for (int b = 0; b < 2; ++b)
#pragma unroll
            for (int m = 0; m < 4; ++m)
#pragma unroll
                for (int n = 0; n < 2; ++n) acc[a][b][m][n] = (f32x4){0.f, 0.f, 0.f, 0.f};
    bf16x8 At[4][2], B0[2][2], B1[2][2];
    const char* cA = (const char*)g.A + (size_t)cur.pm * tstep; const char* cB = (const char*)g.Bt + (size_t)cur.pn * tstep;
    S.a_ready(cur);
    if constexpr (SP2) {
        PG8_STAGE(PG8_SB(0, 0), cB, voffB); PG8_STAGE(PG8_SB(0, 1), cB + hstepB, voffB); PG8_STAGE(PG8_SA(0, 0), cA, voffA); PG8_STAGE(PG8_SA(0, 1), cA + hstepA, voffA);
        if (wr == 1) PG8_BAR;
        PG8_WAIT_V(2); PG8_BAR;
        PG8_STAGE(PG8_SB(1, 0), cB + kstepB, voffB); PG8_STAGE(PG8_SA(1, 0), cA + kstepA, voffA); PG8_STAGE(PG8_SB(1, 1), cB + hstepB + kstepB, voffB);
        PG8_WAIT_V(6); PG8_BAR;
    } else {
        PG8_STAGE(PG8_SB(0, 0), cB, voffB); PG8_STAGE(PG8_SA(0, 0), cA, voffA); PG8_STAGE(PG8_SB(0, 1), cB + hstepB, voffB); PG8_STAGE(PG8_SA(0, 1), cA + hstepA, voffA);
        if (wr == 1) PG8_BAR;
        PG8_WAIT_V(4); PG8_BAR;
        PG8_STAGE(PG8_SB(1, 0), cB + kstepB, voffB); PG8_STAGE(PG8_SA(1, 0), cA + kstepA, voffA); PG8_STAGE(PG8_SB(1, 1), cB + hstepB + kstepB, voffB);
        PG8_WAIT_V(6); PG8_BAR;
    }
    for (;;) {
        const bool has_next = S.next(ui + 1, nxt);
        const char* nA = has_next ? (const char*)g.A + (size_t)nxt.pm * tstep : cA; const char* nB = has_next ? (const char*)g.Bt + (size_t)nxt.pn * tstep : cB;
#pragma clang loop unroll(disable)
        for (int t = 0; t < nt; t += 2) {
            const bool last = (t == nt - 2);
            const char* a1 = cA + (size_t)(t + 1) * kstepA;
            const char* a2 = last ? nA : cA + (size_t)(t + 2) * kstepA; const char* b2 = last ? nB : cB + (size_t)(t + 2) * kstepB;
            const char* a3 = a2 + kstepA; const char* b3 = b2 + kstepB;
            if (last && has_next) S.a_ready(nxt);
            if constexpr (SP2) {
            asm volatile("" : "+v"(voffA[0]), "+v"(voffA[1]), "+v"(voffB[0]), "+v"(voffB[1]));
            PG8_LDB(B0, 0, 0); PG8_LDB(B1, 0, 1); PG8_SCHED; PG8_LDA(At, 0, 0); PG8_STAGE(PG8_SA(1, 1), a1 + hstepA, voffA);
            PG8_WAIT_V(8); PG8_WAIT_L(0); PG8_BAR; PG8_MMA(0, 0, At, B0); PG8_MMA(0, 1, At, B1); PG8_BAR; PG8_SCHED;
            PG8_LDA(At, 0, 1); PG8_STAGE(PG8_SB(0, 0), b2, voffB); PG8_STAGE(PG8_SB(0, 1), b2 + hstepB, voffB); PG8_STAGE(PG8_SA(0, 0), a2, voffA);
            PG8_WAIT_V(8); PG8_WAIT_L(0); PG8_BAR; PG8_MMA(1, 0, At, B0); PG8_MMA(1, 1, At, B1); PG8_BAR; PG8_SCHED;
            PG8_LDB(B0, 1, 0); PG8_LDB(B1, 1, 1); PG8_SCHED; PG8_LDA(At, 1, 0); PG8_STAGE(PG8_SA(0, 1), a2 + hstepA, voffA);
            PG8_WAIT_V(8); PG8_WAIT_L(0); PG8_BAR; PG8_MMA(0, 0, At, B0); PG8_MMA(0, 1, At, B1); PG8_BAR; PG8_SCHED;
            PG8_LDA(At, 1, 1); PG8_STAGE(PG8_SB(1, 0), b3, voffB); PG8_STAGE(PG8_SB(1, 1), b3 + hstepB, voffB); PG8_STAGE(PG8_SA(1, 0), a3, voffA);
            PG8_WAIT_V(8); PG8_WAIT_L(0); PG8_BAR; PG8_MMA(1, 0, At, B0); PG8_MMA(1, 1, At, B1); PG8_BAR; PG8_SCHED;
            } else {
            PG8_LDB(B0, 0, 0); PG8_SCHED; PG8_LDA(At, 0, 0); PG8_STAGE(PG8_SA(1, 1), a1 + hstepA, voffA);
            PG8_WAIT_L(8); PG8_BAR; PG8_WAIT_L(0); PG8_MMA(0, 0, At, B0); PG8_BAR; PG8_SCHED;
            PG8_LDB(B1, 0, 1); PG8_STAGE(PG8_SB(0, 0), b2, voffB);
            PG8_BAR; PG8_WAIT_L(0); PG8_MMA(0, 1, At, B1); PG8_BAR;
            PG8_LDA(At, 0, 1); PG8_STAGE(PG8_SA(0, 0), a2, voffA);
            PG8_BAR; PG8_WAIT_L(0); PG8_MMA(1, 0, At, B0); PG8_BAR; PG8_SCHED;
            PG8_STAGE(PG8_SB(0, 1), b2 + hstepB, voffB);
            PG8_WAIT_V(6); PG8_BAR; PG8_MMA(1, 1, At, B1); PG8_BAR;
            PG8_LDB(B0, 1, 0); PG8_SCHED; PG8_LDA(At, 1, 0); PG8_STAGE(PG8_SA(0, 1), a2 + hstepA, voffA);
            PG8_WAIT_L(8); PG8_BAR; PG8_WAIT_L(0); PG8_MMA(0, 0, At, B0); PG8_BAR; PG8_SCHED;
            PG8_LDB(B1, 1, 1); PG8_STAGE(PG8_SB(1, 0), b3, voffB);
            PG8_BAR; PG8_WAIT_L(0); PG8_MMA(0, 1, At, B1); PG8_BAR;
            PG8_LDA(At, 1, 1); PG8_STAGE(PG8_SA(1, 0), a3, voffA);
            PG8_BAR; PG8_WAIT_L(0); PG8_MMA(1, 0, At, B0); PG8_BAR; PG8_SCHED;
            PG8_STAGE(PG8_SB(1, 1), b3 + hstepB, voffB);
            PG8_WAIT_V(6); PG8_BAR; PG8_MMA(1, 1, At, B1); PG8_BAR;
            }
        }
        if constexpr (ALIGN_EPI) { if (wr == 0) PG8_BAR; }
        E(acc, cur, wr, wc, fr, fq); S.done(cur);
        if (!has_next) break;
#pragma unroll
        for (int a = 0; a < 2; ++a)
#pragma unroll
            for (int b = 0; b < 2; ++b)
#pragma unroll
                for (int m = 0; m < 4; ++m)
#pragma unroll
                    for (int n = 0; n < 2; ++n) acc[a][b][m][n] = (f32x4){0.f, 0.f, 0.f, 0.f};
        cur = nxt; cA = nA; cB = nB; ++ui;
        if constexpr (ALIGN_EPI) { if (wr == 1) PG8_BAR; }
    }
    PG8_WAIT_V(0);
    if constexpr (!ALIGN_EPI) { if (wr == 0) PG8_BAR; }
    PG8_BAR;
#undef PG8_SA
#undef PG8_SB
#undef PG8_STAGE
#undef PG8_LDA
#undef PG8_LDB
#undef PG8_MMA
#undef PG8_WAIT_V
#undef PG8_WAIT_L
#undef PG8_BAR
#undef PG8_SCHED
}
}

constexpr int NWAVES = 8;
constexpr int MTOK = 32768, DM = 2048, DFF = 5632, NGU = 2 * DFF, SEQ = 2048, NBATCH = 16;
constexpr float NORM_EPS = 1e-6f;
constexpr float LAMBDA_INIT = 0.35550906759096926f;
constexpr float QSCALE = 0.08838834764831845f;
constexpr size_t MiB = (size_t)1 << 20;
constexpr size_t WS_CTL = 0, CTL_ZERO_BYTES = 32768;
constexpr size_t WS_TAB = 4 * MiB;
constexpr size_t WS_W = 8 * MiB;
constexpr size_t W_GU = 0, W_DN = 176 * MiB, W_HIN = 264 * MiB, W_HOUT = 296 * MiB, W_KV = 304 * MiB, W_Q = 320 * MiB, W_AO = 328 * MiB, W_PG = 336 * MiB, W_PP = 352 * MiB;
constexpr size_t WS_PB = 364 * MiB;
constexpr size_t WS_HB1 = 396 * MiB, WS_HB2 = 524 * MiB;
constexpr size_t WS_BIG = 652 * MiB;
constexpr size_t WS_STATS = WS_BIG + 640 * MiB;
constexpr size_t WS_END = WS_STATS + 9 * MiB;
constexpr size_t BIG_HID = 0;
constexpr size_t BIG_HQ = 0, BIG_HV = 128 * MiB, BIG_HSG = 256 * MiB, BIG_HLF = 384 * MiB;
constexpr size_t BIG_PP = 384 * MiB;
constexpr size_t BIG_KR = 384 * MiB, BIG_VV = 512 * MiB;
constexpr size_t BIG_QR = 0, BIG_O1 = 128 * MiB, BIG_O2 = 256 * MiB;
constexpr int CW_TMO = 0, CW_CODE = 1, CW_BAR = 4096;

constexpr int RING_OFF = 0, RING_BYTES = 131072;
constexpr int RSTAB_OFF = 131072;
constexpr int LDSCTL_OFF = 147456, MISC_OFF = LDSCTL_OFF + 320;
constexpr int RED_OFF = 148480;
constexpr int LDS_BYTES = 152576;

#define GAS __attribute__((address_space(1)))
#define LAS __attribute__((address_space(3)))
typedef unsigned short bf16;
typedef unsigned v4u __attribute__((ext_vector_type(4)));
typedef unsigned v2u __attribute__((ext_vector_type(2)));
typedef float f32x4 __attribute__((ext_vector_type(4)));
typedef short bf16x8 __attribute__((ext_vector_type(8)));
typedef short s16x4 __attribute__((ext_vector_type(4)));
typedef float f32x2_t __attribute__((ext_vector_type(2)));
typedef __bf16 bf16x2_t __attribute__((ext_vector_type(2)));
typedef GAS unsigned gu32;
typedef unsigned long long u64;
#define RLX_AGENT __ATOMIC_RELAXED, __HIP_MEMORY_SCOPE_AGENT
#define LDS_WAIT() asm volatile("s_waitcnt lgkmcnt(0)" ::: "memory")
#define VM_WAIT() asm volatile("s_waitcnt vmcnt(0)" ::: "memory")
__device__ __forceinline__ unsigned pk2(float lo, float hi) { f32x2_t v = {lo, hi}; bf16x2_t b = __builtin_convertvector(v, bf16x2_t); return __builtin_bit_cast(unsigned, b); }
__device__ __forceinline__ float bf2f(unsigned short b) { return __uint_as_float(((unsigned)b) << 16); }
__device__ __forceinline__ float bflo(unsigned w) { return __uint_as_float(w << 16); }
__device__ __forceinline__ float bfhi(unsigned w) { return __uint_as_float(w & 0xffff0000u); }
__device__ __forceinline__ float fast_sigmoid(float x) { return __builtin_amdgcn_rcpf(1.0f + __builtin_amdgcn_exp2f(-1.4426950408889634f * x)); }
__device__ __forceinline__ float wave_sum(float v) {
#pragma unroll
    for (int o = 1; o < 64; o <<= 1) v += __shfl_xor(v, o);
    return v;
}
__device__ __forceinline__ float stat_rstd(const float* st, int row) {
    float s = 0.f;
#pragma unroll
    for (int p = 0; p < 8; ++p) s += st[(size_t)p * MTOK + row];
    return rsqrtf(s * (1.0f / (float)DM) + NORM_EPS);
}
__device__ __forceinline__ void fill_rstd_table(LAS float* tab, const float* st, int c, int wid) {
    const int tid = wid * 64 + fresh_lane(), base = 4096 * (c & 7);
    float r[8];
#pragma unroll
    for (int i = 0; i < 8; ++i) r[i] = stat_rstd(st, base + tid + 512 * i);
#pragma unroll
    for (int i = 0; i < 8; ++i) tab[tid + 512 * i] = r[i];
    asm volatile("s_waitcnt lgkmcnt(0)" ::: "memory"); __syncthreads();
}
#define XB_TMO      128
#define XB_XCNT(j)  (256  + 64 * (j))
#define XB_XSUB(j)  (1280 + 64 * (j))
#define XB_XGEN(j)  (2304 + 64 * (j))
#define XB_TOP      3328
#define XB_TOPGEN   3392
#define XCD_BAR_WORDS 3456
#define XB_SPIN_CAP (1u << 18)
__device__ __forceinline__ unsigned xb_ld(unsigned* p)              { return __hip_atomic_load(p, __ATOMIC_RELAXED, __HIP_MEMORY_SCOPE_AGENT); }
__device__ __forceinline__ unsigned xb_add(unsigned* p, unsigned v) { return __hip_atomic_fetch_add(p, v, __ATOMIC_RELAXED, __HIP_MEMORY_SCOPE_AGENT); }
__device__ __forceinline__ unsigned xb_xcc_id() { return (unsigned)__builtin_amdgcn_s_getreg((3 << 11) | 20) & 0xFu; }
#define XB_SPIN(cond, bar) do { unsigned _sp = 0; while (cond) { __builtin_amdgcn_s_sleep(1); \
    if ((++_sp & 255u) == 0u) { if (xb_ld(&(bar)[XB_TMO])) break; if (_sp > XB_SPIN_CAP) { atomicAdd(&(bar)[XB_TMO], 1u); break; } } } } while (0)
struct XcdBarrier { unsigned* bar; unsigned x; volatile LAS unsigned* st; };
__device__ __forceinline__ XcdBarrier xcd_barrier_post(unsigned* bar, volatile LAS unsigned* st, int wid) {
    XcdBarrier b; b.bar = bar; b.x = xb_xcc_id(); b.st = st;
    if (wid == 0 && fresh_lane() == 0) (void)xb_add(&bar[XB_XCNT(b.x)], 1u);
    return b;
}
__device__ __forceinline__ void xcd_barrier_complete(unsigned* bar, unsigned x, unsigned& nloc, unsigned& nx) {
    const unsigned G = gridDim.x * gridDim.y * gridDim.z;
    unsigned sum, cnt, mine, sp = 0u;
    for (;;) {
        sum = 0u; cnt = 0u; mine = 0u;
#pragma unroll
        for (unsigned j = 0; j < 16; ++j) { const unsigned c = xb_ld(&bar[XB_XCNT(j)]); sum += c; cnt += (c > 0u) ? 1u : 0u; mine = (j == x) ? c : mine; }
        if (sum == G) break;
        __builtin_amdgcn_s_sleep(1);
        if ((++sp & 255u) == 0u) { if (xb_ld(&bar[XB_TMO])) break; if (sp > XB_SPIN_CAP) { atomicAdd(&bar[XB_TMO], 1u); break; } }
    }
    nloc = mine > 0u ? mine : 1u; nx = cnt > 0u ? cnt : 1u;
}
__device__ __forceinline__ void xcd_barrier(const XcdBarrier& b, int wid) {
    asm volatile("s_waitcnt vmcnt(0)" ::: "memory");
    __syncthreads();
    if (wid == 0 && fresh_lane() == 0) {
        unsigned* bar = b.bar;
        __builtin_amdgcn_s_waitcnt(0);
        unsigned nloc = b.st[0], nx = b.st[1];
        if (nloc == 0u) { xcd_barrier_complete(bar, b.x, nloc, nx); b.st[0] = nloc; b.st[1] = nx; }
        const unsigned old = xb_add(&bar[XB_XSUB(b.x)], 1u);
        const unsigned gen = old / nloc;
        if (old + 1u == (gen + 1u) * nloc) {
            __builtin_amdgcn_fence(__ATOMIC_RELEASE, "agent");
            asm volatile("s_waitcnt vmcnt(0)" ::: "memory");
            const unsigned og = xb_add(&bar[XB_TOP], 1u);
            const unsigned tg = og / nx;
            if (og + 1u == (tg + 1u) * nx) xb_add(&bar[XB_TOPGEN], 1u);
            else XB_SPIN(xb_ld(&bar[XB_TOPGEN]) == tg, bar);
            __builtin_amdgcn_fence(__ATOMIC_ACQUIRE, "agent");
            xb_add(&bar[XB_XGEN(b.x)], 1u);
            asm volatile("s_waitcnt vmcnt(0)" ::: "memory");
        } else {
            XB_SPIN(xb_ld(&bar[XB_XGEN(b.x)]) == gen, bar);
            __builtin_amdgcn_fence(__ATOMIC_ACQUIRE, "agent");
            asm volatile("s_waitcnt vmcnt(0)" ::: "memory");
        }
    }
    __syncthreads();
}

__device__ __forceinline__ float scan16(float x) {
    x += __builtin_bit_cast(float, __builtin_amdgcn_update_dpp(0, __builtin_bit_cast(int, x), 0x111, 0xf, 0xf, true));
    x += __builtin_bit_cast(float, __builtin_amdgcn_update_dpp(0, __builtin_bit_cast(int, x), 0x112, 0xf, 0xf, true));
    x += __builtin_bit_cast(float, __builtin_amdgcn_update_dpp(0, __builtin_bit_cast(int, x), 0x114, 0xf, 0xf, true));
    x += __builtin_bit_cast(float, __builtin_amdgcn_update_dpp(0, __builtin_bit_cast(int, x), 0x118, 0xf, 0xf, true));
    return x;
}
using pg8::Unit;
struct EpiGU {
    static constexpr bool PERM = true;
    bf16* HID; const LAS float* rt;
    __device__ __forceinline__ void operator()(const f32x4 (&acc)[2][2][4][2], const Unit& u, int wr, int wc, int fr, int fq) const {
        const int row0 = u.pm * 256 + wr * 64 + fr, hc = u.pn * 128 + wc * 32 + 8 * fq;
        float rsv[2][4];
#pragma unroll
        for (int ai = 0; ai < 2; ++ai)
#pragma unroll
            for (int m = 0; m < 4; ++m) rsv[ai][m] = rt[(row0 + ai * 128 + m * 16) & 4095];
#pragma unroll
        for (int ai = 0; ai < 2; ++ai)
#pragma unroll
            for (int m = 0; m < 4; ++m) { const int row = row0 + ai * 128 + m * 16; const float rs = rsv[ai][m], rs2 = rs * rs, rsl = -1.4426950408889634f * rs;
                float h[8];
#pragma unroll
                for (int n = 0; n < 2; ++n)
#pragma unroll
                    for (int j = 0; j < 4; ++j) { const float ga = acc[ai][0][m][n][j], ua = acc[ai][1][m][n][j];
                        h[4 * n + j] = (ga * ua) * rs2 * __builtin_amdgcn_rcpf(1.0f + __builtin_amdgcn_exp2f(ga * rsl)); }
                v4u w; w.x = pk2(h[0], h[1]); w.y = pk2(h[2], h[3]); w.z = pk2(h[4], h[5]); w.w = pk2(h[6], h[7]);
                __builtin_nontemporal_store(w, (v4u*)(HID + (size_t)(row >> 8) * (256 * DFF) + (size_t)(hc >> 6) * 16384 + (row & 255) * 64 + (hc & 63))); }
    }
};
__device__ __forceinline__ void row_stat_store(LAS float* red, float* st, const Unit& u, int wr, int wc, int fr, int fq, const float (&part)[2][4]) {
    if (fq == 0) {
#pragma unroll
        for (int ai = 0; ai < 2; ++ai)
#pragma unroll
            for (int m = 0; m < 4; ++m) red[wc * 256 + ai * 128 + wr * 64 + m * 16 + fr] = part[ai][m];
    }
    asm volatile("s_waitcnt lgkmcnt(0)" ::: "memory"); __builtin_amdgcn_s_barrier(); asm volatile("" ::: "memory");
    const int t = (wr * 4 + wc) * 64 + fq * 16 + fr;
    if (t < 256) { const float sum = (red[t] + red[256 + t]) + (red[512 + t] + red[768 + t]); st[(size_t)u.pn * MTOK + u.pm * 256 + t] = sum; }
}
template <bool F32BASE> struct EpiRes {
    static constexpr bool PERM = true;
    const void* basep; bf16* HB; float* st; float alpha; LAS float* red;
    __device__ __forceinline__ void operator()(const f32x4 (&acc)[2][2][4][2], const Unit& u, int wr, int wc, int fr, int fq) const {
        const int row0 = u.pm * 256 + wr * 64 + fr, c0 = u.pn * 256 + wc * 32 + 8 * fq;
        float part[2][4];
        constexpr int NB = F32BASE ? 2 : 4, NG = 8 / NB, GPA = 4 / NB;
        v4u raw[2][NB][2]; f32x4 bf[2][NB][2][2];
#define RES_LOAD(g, sl) do { _Pragma("unroll") for (int mm = 0; mm < NB; ++mm) { const size_t off = (size_t)(row0 + ((g) / GPA) * 128 + (((g) % GPA) * NB + mm) * 16) * DM + c0; \
            _Pragma("unroll") for (int bj = 0; bj < 2; ++bj) { \
                if constexpr (F32BASE) { const float* base = (const float*)basep; bf[sl][mm][bj][0] = *(const f32x4*)(base + off + bj * 128); bf[sl][mm][bj][1] = *(const f32x4*)(base + off + bj * 128 + 4); } \
                else raw[sl][mm][bj] = *(const v4u*)((const bf16*)basep + off + bj * 128); } } } while (0)
        RES_LOAD(0, 0);
#pragma unroll
        for (int g = 0; g < NG; ++g) { const int ai = g / GPA, mb = g % GPA, sl = g & 1;
            if (g + 1 < NG) RES_LOAD(g + 1, (g + 1) & 1);
#pragma unroll
            for (int mm = 0; mm < NB; ++mm) { const int m = mb * NB + mm; const int row = row0 + ai * 128 + m * 16; const size_t off = (size_t)row * DM + c0; float ss = 0.f;
#pragma unroll
                for (int bj = 0; bj < 2; ++bj) { f32x4 b0, b1;
                    if constexpr (F32BASE) { b0 = bf[sl][mm][bj][0]; b1 = bf[sl][mm][bj][1]; }
                    else { const v4u r = raw[sl][mm][bj]; b0 = (f32x4){bflo(r.x), bfhi(r.x), bflo(r.y), bfhi(r.y)}; b1 = (f32x4){bflo(r.z), bfhi(r.z), bflo(r.w), bfhi(r.w)}; }
                    const f32x4 v0 = b0 + alpha * acc[ai][bj][m][0], v1 = b1 + alpha * acc[ai][bj][m][1];
                    v4u w; w.x = pk2(v0[0], v0[1]); w.y = pk2(v0[2], v0[3]); w.z = pk2(v1[0], v1[1]); w.w = pk2(v1[2], v1[3]);
                    *(v4u*)(HB + off + bj * 128) = w;
                    ss += (v0[0] * v0[0] + v0[1] * v0[1]) + (v0[2] * v0[2] + v0[3] * v0[3]) + (v1[0] * v1[0] + v1[1] * v1[1]) + (v1[2] * v1[2] + v1[3] * v1[3]); }
                ss += __shfl_xor(ss, 16); ss += __shfl_xor(ss, 32); part[ai][m] = ss; }
            asm volatile("" ::: "memory"); }
#undef RES_LOAD
        row_stat_store(red, st, u, wr, wc, fr, fq, part);
    }
};
struct EpiPleG {
    static constexpr bool PERM = true;
    const bf16* base; bf16* HB; float* st; const LAS float* rt; const bf16* PP; LAS float* red;
    __device__ __forceinline__ void operator()(const f32x4 (&acc)[2][2][4][2], const Unit& u, int wr, int wc, int fr, int fq) const {
        const int row0 = u.pm * 256 + wr * 64 + fr, c0 = u.pn * 256 + wc * 32 + 8 * fq;
        float part[2][4];
        v4u bv[2][2][2], pv[2][2][2];
#define PG_LOAD(g, sl) do { _Pragma("unroll") for (int mm = 0; mm < 2; ++mm) { const int row = row0 + ((g) >> 1) * 128 + (2 * ((g) & 1) + mm) * 16; const size_t off = (size_t)row * DM + c0; \
            _Pragma("unroll") for (int bj = 0; bj < 2; ++bj) { bv[sl][mm][bj] = *(const v4u*)(base + off + bj * 128); pv[sl][mm][bj] = *(const v4u*)(PP + off + bj * 128); } } } while (0)
        PG_LOAD(0, 0);
#pragma unroll
        for (int g = 0; g < 4; ++g) { const int ai = g >> 1, mb = g & 1, sl = g & 1;
            if (g + 1 < 4) PG_LOAD(g + 1, (g + 1) & 1);
#pragma unroll
            for (int mm = 0; mm < 2; ++mm) { const int m = 2 * mb + mm; const int row = row0 + ai * 128 + m * 16; const size_t off = (size_t)row * DM + c0; float ss = 0.f;
                const float rs = rt[row & 4095];
#pragma unroll
                for (int bj = 0; bj < 2; ++bj) { const v4u b = bv[sl][mm][bj], p = pv[sl][mm][bj];
                    const float bb[8] = {bflo(b.x), bfhi(b.x), bflo(b.y), bfhi(b.y), bflo(b.z), bfhi(b.z), bflo(b.w), bfhi(b.w)};
                    const float pp[8] = {bflo(p.x), bfhi(p.x), bflo(p.y), bfhi(p.y), bflo(p.z), bfhi(p.z), bflo(p.w), bfhi(p.w)};
                    float v[8];
#pragma unroll
                    for (int n = 0; n < 2; ++n)
#pragma unroll
                        for (int j = 0; j < 4; ++j) { v[4 * n + j] = bb[4 * n + j] + fast_sigmoid(acc[ai][bj][m][n][j] * rs) * pp[4 * n + j]; ss += v[4 * n + j] * v[4 * n + j]; }
                    v4u w; w.x = pk2(v[0], v[1]); w.y = pk2(v[2], v[3]); w.z = pk2(v[4], v[5]); w.w = pk2(v[6], v[7]);
                    *(v4u*)(HB + off + bj * 128) = w; }
                ss += __shfl_xor(ss, 16); ss += __shfl_xor(ss, 32); part[ai][m] = ss; }
            asm volatile("" ::: "memory"); }
#undef PG_LOAD
        row_stat_store(red, st, u, wr, wc, fr, fq, part);
    }
};
struct EpiPlain {
    static constexpr bool PERM = true;
    bf16* C;
    __device__ __forceinline__ void operator()(const f32x4 (&acc)[2][2][4][2], const Unit& u, int wr, int wc, int fr, int fq) const {
        const int row0 = u.pm * 256 + wr * 64 + fr, c0 = u.pn * 256 + wc * 32 + 8 * fq;
#pragma unroll
        for (int ai = 0; ai < 2; ++ai)
#pragma unroll
            for (int m = 0; m < 4; ++m) { bf16* rp = C + (size_t)(row0 + ai * 128 + m * 16) * DM + c0;
#pragma unroll
                for (int bj = 0; bj < 2; ++bj) { const f32x4 a = acc[ai][bj][m][0], b = acc[ai][bj][m][1];
                    v4u w; w.x = pk2(a[0], a[1]); w.y = pk2(a[2], a[3]); w.z = pk2(b[0], b[1]); w.w = pk2(b[2], b[3]);
                    *(v4u*)(rp + bj * 128) = w; } }
    }
};
struct EpiHgIn {
    static constexpr bool PERM = true;
    bf16* Q; float* LF; bf16* V; bf16* SG; const LAS float* rt; const float* lb;
    __device__ __forceinline__ void operator()(const f32x4 (&acc)[2][2][4][2], const Unit& u, int wr, int wc, int fr, int fq) const {
        const int region = u.pn >> 3; const int row0 = u.pm * 256 + wr * 64 + fr, c0 = (u.pn & 7) * 256 + wc * 32 + 8 * fq;
        float rsv[2][4];
#pragma unroll
        for (int ai = 0; ai < 2; ++ai)
#pragma unroll
            for (int m = 0; m < 4; ++m) rsv[ai][m] = rt[(row0 + ai * 128 + m * 16) & 4095];
        if (region == 1) {
            f32x4 lbv[2][2];
#pragma unroll
            for (int bj = 0; bj < 2; ++bj) { lbv[bj][0] = *(const f32x4*)(lb + c0 + bj * 128); lbv[bj][1] = *(const f32x4*)(lb + c0 + bj * 128 + 4); }
            const int src15 = fq * 16 + 15;
#pragma unroll
            for (int ai = 0; ai < 2; ++ai)
#pragma unroll
                for (int mp = 0; mp < 2; ++mp) { const int rowa = row0 + ai * 128 + (2 * mp) * 16, rowb = rowa + 16; const float rsa = rsv[ai][2 * mp], rsb = rsv[ai][2 * mp + 1];
#pragma unroll
                    for (int bj = 0; bj < 2; ++bj) { float xa[8], xb[8];
#pragma unroll
                        for (int n = 0; n < 2; ++n)
#pragma unroll
                            for (int j = 0; j < 4; ++j) { const float l = lbv[bj][n][j], om = 1.0f - l;
                                const float sa = fast_sigmoid(acc[ai][bj][2 * mp][n][j] * rsa), sb = fast_sigmoid(acc[ai][bj][2 * mp + 1][n][j] * rsb);
                                xa[4 * n + j] = __log2f(l + om * sa); xb[4 * n + j] = __log2f(l + om * sb); }
#pragma unroll
                        for (int e = 0; e < 8; ++e) { xa[e] = scan16(xa[e]); xb[e] = scan16(xb[e]) + __shfl(xa[e], src15); }
                        float* pa = LF + (size_t)rowa * DM + c0 + bj * 128; float* pb = LF + (size_t)rowb * DM + c0 + bj * 128;
                        __builtin_nontemporal_store((f32x4){xa[0], xa[1], xa[2], xa[3]}, (f32x4*)pa); __builtin_nontemporal_store((f32x4){xa[4], xa[5], xa[6], xa[7]}, (f32x4*)(pa + 4));
                        __builtin_nontemporal_store((f32x4){xb[0], xb[1], xb[2], xb[3]}, (f32x4*)pb); __builtin_nontemporal_store((f32x4){xb[4], xb[5], xb[6], xb[7]}, (f32x4*)(pb + 4));
 } }
        } else {
            const size_t roff = region == 0 ? 0 : (region == 2 ? (size_t)(BIG_HV - BIG_HQ) : (size_t)(BIG_HSG - BIG_HQ));
            bf16* O = (bf16*)((unsigned char*)Q + roff);
#pragma unroll
            for (int ai = 0; ai < 2; ++ai)
#pragma unroll
                for (int m = 0; m < 4; ++m) { const int row = row0 + ai * 128 + m * 16; const float rs = rsv[ai][m]; bf16* rp = O + (size_t)row * DM + c0;
#pragma unroll
                    for (int bj = 0; bj < 2; ++bj) { float h[8];
#pragma unroll
                        for (int n = 0; n < 2; ++n)
#pragma unroll
                            for (int j = 0; j < 4; ++j) { float x = acc[ai][bj][m][n][j] * rs; if (region == 3) x = x * fast_sigmoid(x); h[4 * n + j] = x; }
                        v4u w; w.x = pk2(h[0], h[1]); w.y = pk2(h[2], h[3]); w.z = pk2(h[4], h[5]); w.w = pk2(h[6], h[7]);
                        __builtin_nontemporal_store(w, (v4u*)(rp + bj * 128)); } }
        }
    }
};
struct EpiRope {
    static constexpr bool PERM = true;
    bf16* O; bf16* V2; int nrope; const LAS float* rt; const float* cs; const float* sn;
    __device__ __forceinline__ void operator()(const f32x4 (&acc)[2][2][4][2], const Unit& u, int wr, int wc, int fr, int fq) const {
        const int row0 = u.pm * 256 + wr * 64 + fr;
        float rsv[2][4];
#pragma unroll
        for (int ai = 0; ai < 2; ++ai)
#pragma unroll
            for (int m = 0; m < 4; ++m) rsv[ai][m] = rt[(row0 + ai * 128 + m * 16) & 4095];
        if (u.pn < nrope) {
            const int comp = wc >> 1, dl = 32 * (wc & 1) + 8 * fq, oc = u.pn * 256 + comp * 128 + dl;
#pragma unroll
            for (int ai = 0; ai < 2; ++ai) {
                f32x4 cv[4][2], sv[4][2];
#pragma unroll
                for (int m = 0; m < 4; ++m) { const int pos = (row0 + ai * 128 + m * 16) & (SEQ - 1);
#pragma unroll
                    for (int n = 0; n < 2; ++n) { cv[m][n] = *(const f32x4*)(cs + pos * 64 + dl + 4 * n); sv[m][n] = *(const f32x4*)(sn + pos * 64 + dl + 4 * n); } }
#pragma unroll
                for (int m = 0; m < 4; ++m) { const int row = row0 + ai * 128 + m * 16; const float rs = rsv[ai][m];
                    float o1[8], o2[8];
#pragma unroll
                    for (int n = 0; n < 2; ++n) {
#pragma unroll
                        for (int j = 0; j < 4; ++j) { const float x1 = acc[ai][0][m][n][j] * rs, x2 = acc[ai][1][m][n][j] * rs; const float c = cv[m][n][j], sj = sv[m][n][j]; o1[4 * n + j] = x1 * c - x2 * sj; o2[4 * n + j] = x2 * c + x1 * sj; } }
                    v4u w1, w2; w1.x = pk2(o1[0], o1[1]); w1.y = pk2(o1[2], o1[3]); w1.z = pk2(o1[4], o1[5]); w1.w = pk2(o1[6], o1[7]);
                    w2.x = pk2(o2[0], o2[1]); w2.y = pk2(o2[2], o2[3]); w2.z = pk2(o2[4], o2[5]); w2.w = pk2(o2[6], o2[7]);
                    bf16* rp = O + (size_t)row * DM + oc; __builtin_nontemporal_store(w1, (v4u*)rp); __builtin_nontemporal_store(w2, (v4u*)(rp + 64)); } }
        } else {
            const int c0 = (u.pn - nrope) * 256 + wc * 32 + 8 * fq;
#pragma unroll
            for (int ai = 0; ai < 2; ++ai)
#pragma unroll
                for (int m = 0; m < 4; ++m) { const int row = row0 + ai * 128 + m * 16; const float rs = rsv[ai][m]; bf16* rp = V2 + (size_t)row * DM + c0;
#pragma unroll
                    for (int bj = 0; bj < 2; ++bj) { const f32x4 a = acc[ai][bj][m][0] * rs, b = acc[ai][bj][m][1] * rs;
                        v4u w; w.x = pk2(a[0], a[1]); w.y = pk2(a[2], a[3]); w.z = pk2(b[0], b[1]); w.w = pk2(b[2], b[3]);
                        __builtin_nontemporal_store(w, (v4u*)(rp + bj * 128)); } }
        }
    }
};

namespace att {
constexpr int D = 128, LDX = 2048;
constexpr float SCALE = 0.08838834764831845f;
constexpr float THR = 8.f;
constexpr int NW = 8, QBLK = 32, KVBLK = 64, QB = NW * QBLK;
constexpr int SHM_V = KVBLK * 256 * 2, SHM_K = KVBLK * D * 2;
constexpr int LDS_ATT = 2 * SHM_V + 2 * SHM_K + NW * 64 * 4;
typedef float f32x16 __attribute__((ext_vector_type(16)));
typedef unsigned u32x4 __attribute__((ext_vector_type(4)));
#define KSWZ(row, colB) ((row) * 256 + ((colB) ^ (((row) & 7) << 4)))
#define SBAR() __builtin_amdgcn_sched_barrier(0)
__device__ __forceinline__ int v_st(int k, int c) { const int kk = (k & ~0xC) | ((k & 4) << 1) | ((k & 8) >> 1); return ((kk >> 3) * 4 + (c >> 5)) * 512 + ((kk & 7) * 32 + (c & 31)) * 2; }
__device__ __forceinline__ int v_rd_base(int lane) { return ((lane & 3) << 3) | (((lane >> 2) & 3) << 6) | (((lane >> 4) & 1) << 5) | (((lane >> 5) & 1) << 8); }
constexpr int v_rd_off(int d0, int ks, int half) { return d0 * 512 + ks * 4096 + half * 2048; }
__device__ __forceinline__ int crow(int r, int hi) { return (r & 3) + 8 * (r >> 2) + 4 * hi; }
__device__ __forceinline__ unsigned cvtpk(float lo, float hi) { return pk2(lo, hi); }
__device__ __forceinline__ bf16x8 load8(const bf16* p) { return *reinterpret_cast<const bf16x8*>(p); }
__device__ __forceinline__ void mask_tile(f32x16& p0, f32x16& p1, int dq, unsigned W) {
    const float NEG = -__builtin_inff();
#pragma unroll
    for (int r = 0; r < 16; ++r) {
        const int c = (r & 3) + 8 * (r >> 2);
        if ((unsigned)(dq - c) >= W) p0[r] = NEG;
        if ((unsigned)(dq - c - 32) >= W) p1[r] = NEG;
    }
}
__device__ __forceinline__ void partialSM(f32x16& p0, f32x16& p1, float& m_reg, float& mn, float& alpha) {
    float pmax = p0[0]; for (int r = 1; r < 16; ++r) pmax = fmaxf(pmax, p0[r]); for (int r = 0; r < 16; ++r) pmax = fmaxf(pmax, p1[r]);
    { auto rr = __builtin_amdgcn_permlane32_swap(__float_as_uint(pmax), __float_as_uint(pmax), false, false);
      pmax = fmaxf(__uint_as_float(rr[0]), __uint_as_float(rr[1])); }
    constexpr float C2 = 1.4426950408889634f * SCALE;
    if (__builtin_expect(__all((pmax - m_reg) * SCALE <= THR), 1)) { mn = m_reg; alpha = 1.f; }
    else { mn = fmaxf(m_reg, pmax); alpha = __builtin_amdgcn_exp2f((m_reg - mn) * C2); m_reg = mn; }
    const float mnL = -mn * C2;
    for (int r = 0; r < 16; ++r) p0[r] = fmaf(p0[r], C2, mnL); for (int r = 0; r < 16; ++r) p1[r] = fmaf(p1[r], C2, mnL);
    for (int r = 0; r < 16; ++r) p0[r] = __builtin_amdgcn_exp2f(p0[r]);
}
__device__ __forceinline__ void finishSM(f32x16& p0, f32x16& p1, float alpha, float& l_reg, bf16x8& pa0, bf16x8& pa1, bf16x8& pa2, bf16x8& pa3) {
    for (int r = 0; r < 16; ++r) p1[r] = __builtin_amdgcn_exp2f(p1[r]);
    float ps = 0; for (int r = 0; r < 16; ++r) ps += p0[r]; for (int r = 0; r < 16; ++r) ps += p1[r];
    { auto rr = __builtin_amdgcn_permlane32_swap(__float_as_uint(ps), __float_as_uint(ps), false, false);
      ps = __uint_as_float(rr[0]) + __uint_as_float(rr[1]); }
    l_reg = l_reg * alpha + ps;
#define PK4(P, B_, OUT) do { unsigned a0 = cvtpk(P[B_+0], P[B_+1]), a1 = cvtpk(P[B_+2], P[B_+3]);                          \
        unsigned b0 = cvtpk(P[B_+4], P[B_+5]), b1 = cvtpk(P[B_+6], P[B_+7]);                                             \
        auto r0 = __builtin_amdgcn_permlane32_swap(a0, b0, false, false); auto r1 = __builtin_amdgcn_permlane32_swap(a1, b1, false, false); \
        u32x4 w = {r0[0], r1[0], r0[1], r1[1]}; OUT = *reinterpret_cast<bf16x8*>(&w); } while (0)
    PK4(p0, 0, pa0); PK4(p0, 8, pa1); PK4(p1, 0, pa2); PK4(p1, 8, pa3);
#undef PK4
}
template <int KB>
__device__ __forceinline__ void qkt(f32x16& p0, f32x16& p1, const char* K_lds, int r32, int hi, const bf16x8* qr) {
    p0 = f32x16{}; p1 = f32x16{};
    const char* kb[4];
#pragma unroll
    for (int dd = 0; dd < 4; ++dd) kb[dd] = K_lds + KB * SHM_K + KSWZ(r32, (dd * 16 + hi * 8) * 2);
#pragma unroll
    for (int d0 = 0; d0 < 8; ++d0) { const char* a = kb[d0 & 3] + (d0 >> 2) * 128;
        bf16x8 b0 = *reinterpret_cast<const bf16x8*>(a);
        bf16x8 b1 = *reinterpret_cast<const bf16x8*>(a + 32 * 256);
        p0 = __builtin_amdgcn_mfma_f32_32x32x16_bf16(b0, qr[d0], p0, 0, 0, 0);
        p1 = __builtin_amdgcn_mfma_f32_32x32x16_bf16(b1, qr[d0], p1, 0, 0, 0); }
}
template <int VB>
__device__ __forceinline__ void pv_tile(f32x16* o, int vb0, bf16x8 pa0, bf16x8 pa1, bf16x8 pa2, bf16x8 pa3) {
#define TRRD(dst, off) asm volatile("ds_read_b64_tr_b16 %0, %1 offset:%2" : "=&v"(dst) : "v"(vb0), "i"(off) : "memory")
#define PV_D0(d0) do { s16x4 l0, l1, l2, l3, h0, h1, h2, h3; constexpr int b_ = VB * SHM_V + (d0) * 512; \
        TRRD(l0, b_); TRRD(h0, b_ + 4096); TRRD(l1, b_ + 8192); TRRD(h1, b_ + 12288); TRRD(l2, b_ + 16384); TRRD(h2, b_ + 20480); TRRD(l3, b_ + 24576); TRRD(h3, b_ + 28672); \
        asm volatile("s_waitcnt lgkmcnt(0)" ::: "memory"); SBAR();   \
        o[d0] = __builtin_amdgcn_mfma_f32_32x32x16_bf16(pa0, (bf16x8){l0[0], l0[1], l0[2], l0[3], h0[0], h0[1], h0[2], h0[3]}, o[d0], 0, 0, 0);   \
        o[d0] = __builtin_amdgcn_mfma_f32_32x32x16_bf16(pa1, (bf16x8){l1[0], l1[1], l1[2], l1[3], h1[0], h1[1], h1[2], h1[3]}, o[d0], 0, 0, 0);   \
        o[d0] = __builtin_amdgcn_mfma_f32_32x32x16_bf16(pa2, (bf16x8){l2[0], l2[1], l2[2], l2[3], h2[0], h2[1], h2[2], h2[3]}, o[d0], 0, 0, 0);   \
        o[d0] = __builtin_amdgcn_mfma_f32_32x32x16_bf16(pa3, (bf16x8){l3[0], l3[1], l3[2], l3[3], h3[0], h3[1], h3[2], h3[3]}, o[d0], 0, 0, 0); } while (0)
    PV_D0(0); PV_D0(1); PV_D0(2); PV_D0(3); PV_D0(4); PV_D0(5); PV_D0(6); PV_D0(7);
#undef PV_D0
#undef TRRD
}
struct BlockRef { const bf16* Q; const bf16* K; const bf16* V; bf16* O; int P0; const bf16* O1r; bf16* H; float lam; int comb; };
#define VMW() asm volatile("s_waitcnt vmcnt(0)" ::: "memory")
__device__ __forceinline__ void causal_block(const BlockRef& cur, char* lds, const int wid) {
    const int W = 1 << 30;
    const int lane = fresh_lane(), tid = wid * 64 + lane, r32 = lane & 31, hi = lane >> 5;
    const int NT = cur.P0 / KVBLK + 4;
    const int qlo = cur.P0 + wid * QBLK, qm = qlo + r32 - 4 * hi;
    char* V_lds = lds; char* K_lds = lds + 2 * SHM_V;
    float* ws = (float*)(lds + 2 * SHM_V + 2 * SHM_K) + wid * 64; float* li_l = ws, * al_l = ws + 32;
    const int vb0 = (int)(uintptr_t)V_lds + v_rd_base(lane);
    unsigned ko[2], vo[4];
#pragma unroll
    for (int i = 0; i < 2; ++i) { const int b = 16 * (tid + 512 * i), row = b >> 8, colB = (b & 255) ^ ((row & 7) << 4); ko[i] = (unsigned)(row * LDX * 2 + colB); }
#pragma unroll
    for (int i = 0; i < 4; ++i) { const int b = 16 * (tid + 512 * i), idx = b >> 9, within = b & 511, kk = (idx >> 3) * 8 + (within >> 6), c = (idx & 7) * 32 + ((within & 63) >> 1);
        const int k = (kk & ~0xC) | ((kk & 4) << 1) | ((kk & 8) >> 1); vo[i] = (unsigned)((k * LDX + c) * 2); }
    typedef __attribute__((address_space(3))) unsigned lds_u32;
#define DMA_TILE(t, bf) do { const char* kg_ = (const char*)cur.K + (size_t)(t) * (KVBLK * LDX * 2); const char* vg_ = (const char*)cur.V + (size_t)(t) * (KVBLK * LDX * 2); \
        asm volatile("" : "+s"(kg_), "+s"(vg_)); asm volatile("" : "+v"(ko[0]), "+v"(ko[1]), "+v"(vo[0]), "+v"(vo[1]), "+v"(vo[2]), "+v"(vo[3]));        \
        _Pragma("unroll") for (int i_ = 0; i_ < 2; ++i_) __builtin_amdgcn_global_load_lds((const unsigned*)(kg_ + ko[i_]), (lds_u32*)(unsigned)(uintptr_t)(K_lds + (bf) * SHM_K + i_ * 8192 + wid * 1024), 16, 0, 0); \
        _Pragma("unroll") for (int i_ = 0; i_ < 4; ++i_) __builtin_amdgcn_global_load_lds((const unsigned*)(vg_ + vo[i_]), (lds_u32*)(unsigned)(uintptr_t)(V_lds + (bf) * SHM_V + i_ * 8192 + wid * 1024), 16, 0, 0); } while (0)
    bf16x8 qr[8];
#pragma unroll
    for (int d0 = 0; d0 < 8; ++d0) qr[d0] = load8(cur.Q + (size_t)(wid * QBLK + r32) * LDX + d0 * 16 + hi * 8);
    DMA_TILE(0, 0);
    float m_reg = -1e30f, l_reg = 0; f32x16 o[8] = {};
    VMW(); __syncthreads();
#define RESC(a) do { if (__any((a) < 1.f)) { if (hi == 0) al_l[r32] = (a); asm volatile("s_waitcnt lgkmcnt(0)" ::: "memory");              \
                     for (int d_ = 0; d_ < 8; ++d_) for (int r = 0; r < 16; ++r) o[d_][r] *= al_l[crow(r, hi)]; } } while (0)
#define MASKT(P0_, P1_, t) do { const int kb_ = (t) * KVBLK; if (kb_ + KVBLK - 1 > qlo) mask_tile(P0_, P1_, qm - kb_, (unsigned)W); } while (0)
#define STEP(t, BF) do { f32x16 p0, p1; float mn, al; bf16x8 pa0, pa1, pa2, pa3;                                   \
        if ((t) + 1 < NT) DMA_TILE((t) + 1, (BF) ^ 1);                                                              \
        if ((t) * KVBLK <= qlo + QBLK - 1) {         \
        SBAR(); qkt<BF>(p0, p1, K_lds, r32, hi, qr); SBAR();                                                        \
        MASKT(p0, p1, (t)); partialSM(p0, p1, m_reg, mn, al); RESC(al);                                             \
        finishSM(p0, p1, al, l_reg, pa0, pa1, pa2, pa3); SBAR();                                                    \
        pv_tile<BF>(o, vb0, pa0, pa1, pa2, pa3); }                                                                  \
        VMW(); __syncthreads(); } while (0)
    for (int t = 0; t < NT; t += 2) { STEP(t, 0); STEP(t + 1, 1); }
    if (hi == 0) li_l[r32] = l_reg; asm volatile("s_waitcnt lgkmcnt(0)" ::: "memory");
    if (!cur.comb) {
    float rli[16];
#pragma unroll
    for (int r = 0; r < 16; ++r) rli[r] = __builtin_amdgcn_rcpf(li_l[crow(r, hi)]);
    bf16* Ow = cur.O + (size_t)(wid * QBLK) * LDX;
#pragma unroll
    for (int r = 0; r < 16; ++r) { const int orow = crow(r, hi);
#pragma unroll
        for (int d0 = 0; d0 < 8; ++d0) { const float v = o[d0][r] * rli[r];
            const float vn = __builtin_bit_cast(float, __builtin_amdgcn_update_dpp(0, __builtin_bit_cast(int, v), 0xB1, 0xf, 0xf, true));
            if ((r32 & 1) == 0) *(unsigned*)(Ow + (size_t)orow * LDX + d0 * 32 + r32) = cvtpk(v, vn); } }
    } else {
    const int ln_ = fresh_lane(), r32 = ln_ & 31, hi = ln_ >> 5;
    const bool oddl = (r32 & 1) != 0; const float lam = cur.lam;
    const char* O1u = (const char*)(cur.O1r + (size_t)(wid * QBLK) * LDX); char* Hu = (char*)(cur.H + (size_t)(wid * QBLK) * LDX);
    const unsigned lo_ = (unsigned)((4 * hi * LDX + (r32 & ~1)) * 2), so_ = (unsigned)((4 * hi * LDX + r32) * 2);
#define RC_(r) ((size_t)((((r) & 3) + 8 * ((r) >> 2)) * LDX * 2))
    unsigned wn[4][8];
#pragma unroll
    for (int i = 0; i < 4; ++i)
#pragma unroll
        for (int d0 = 0; d0 < 8; ++d0) wn[i][d0] = *(const unsigned*)(O1u + RC_(i) + d0 * 64 + (size_t)lo_);
#pragma unroll
    for (int bt = 0; bt < 4; ++bt) { unsigned wc[4][8];
#pragma unroll
        for (int i = 0; i < 4; ++i)
#pragma unroll
            for (int d0 = 0; d0 < 8; ++d0) wc[i][d0] = wn[i][d0];
        if (bt < 3) {
#pragma unroll
            for (int i = 0; i < 4; ++i)
#pragma unroll
                for (int d0 = 0; d0 < 8; ++d0) wn[i][d0] = *(const unsigned*)(O1u + RC_(4 * bt + 4 + i) + d0 * 64 + (size_t)lo_); }
        asm volatile("" ::: "memory");
        float dv[4][8];
#pragma unroll
        for (int i = 0; i < 4; ++i) { const int r = 4 * bt + i; const float rl = __builtin_amdgcn_rcpf(li_l[crow(r, hi)]); float ss = 0.f;
#pragma unroll
            for (int d0 = 0; d0 < 8; ++d0) { const float dd = (oddl ? bfhi(wc[i][d0]) : bflo(wc[i][d0])) - lam * (o[d0][r] * rl); dv[i][d0] = dd; ss += dd * dd; }
            ss += __builtin_bit_cast(float, __builtin_amdgcn_update_dpp(0, __builtin_bit_cast(int, ss), 0xB1, 0xf, 0xf, true));
            ss += __builtin_bit_cast(float, __builtin_amdgcn_update_dpp(0, __builtin_bit_cast(int, ss), 0x4E, 0xf, 0xf, true));
            ss += __builtin_bit_cast(float, __builtin_amdgcn_update_dpp(0, __builtin_bit_cast(int, ss), 0x141, 0xf, 0xf, true));
            ss += __builtin_bit_cast(float, __builtin_amdgcn_update_dpp(0, __builtin_bit_cast(int, ss), 0x140, 0xf, 0xf, true));
            ss += __builtin_bit_cast(float, __builtin_amdgcn_ds_bpermute((ln_ ^ 16) << 2, __builtin_bit_cast(int, ss)));
            const float rs = rsqrtf(ss * (1.0f / 256.0f) + NORM_EPS);
#pragma unroll
            for (int d0 = 0; d0 < 8; ++d0) dv[i][d0] *= rs; }
#pragma unroll
        for (int i = 0; i < 4; ++i) {
#pragma unroll
            for (int d0 = 0; d0 < 8; ++d0) { const float v = dv[i][d0]; const float vn = __builtin_bit_cast(float, __builtin_amdgcn_update_dpp(0, __builtin_bit_cast(int, v), 0xB1, 0xf, 0xf, true));
                if (!oddl) *(unsigned*)(Hu + RC_(4 * bt + i) + d0 * 64 + (size_t)so_) = cvtpk(v, vn); } }
        asm volatile("" ::: "memory"); }
#undef RC_
    }
    __syncthreads();
#undef RESC
#undef MASKT
#undef STEP
#undef DMA_TILE
}
#undef VMW
#undef KSWZ
#undef SBAR
__device__ __forceinline__ BlockRef make_ref(int L, int pass, int comp, const bf16* Q, const bf16* K, const bf16* V, bf16* O1, bf16* H, float lam) {
    const int xcd = L & 7, k = L >> 3, g = (k >> 2) * 8 + xcd, x = k & 3;
    const int b = g >> 3, head = g & 7, qb = pass ? 7 - x : x;
    const size_t rowb = (size_t)b * SEQ * LDX, blk = rowb + (size_t)qb * QB * LDX + head * 256;
    BlockRef R;
    R.Q = Q + blk + comp * 128;
    R.K = K + rowb + head * 256 + comp * 128;
    R.V = V + rowb + head * 256;
    R.O = O1 + blk; R.O1r = O1 + blk; R.H = H + blk; R.lam = lam; R.comb = comp;
    R.P0 = qb * QB;
    return R;
}
__device__ __forceinline__ void attn_phase(char* lds, const bf16* Q, const bf16* K, const bf16* V, bf16* O1, bf16* H, float lam, int G, int bx, const int wid) {
    constexpr int total = 512;
    for (int L = bx; L < total; L += G)
#pragma unroll 1
        for (int pc = 0; pc < 4; ++pc) { const BlockRef cur = make_ref(L, pc >> 1, pc & 1, Q, K, V, O1, H, lam); causal_block(cur, lds, wid); }
}
}

struct Args { const float* in[20]; float* out; unsigned char* ws; int ph_lo, ph_hi; };
constexpr int NPHASE = 19;

#define CAS __attribute__((address_space(4)))
__device__ __forceinline__ const CAS unsigned char* karg_base() { const CAS unsigned char* ka = (const CAS unsigned char*)__builtin_amdgcn_kernarg_segment_ptr(); asm volatile("" : "+s"(ka)); return ka; }
__device__ __forceinline__ const float* arg_in(int k) { return *(const float* const CAS*)(karg_base() + 8 * k); }
__device__ __forceinline__ float* arg_out() { return *(float* const CAS*)(karg_base() + 160); }
__device__ __forceinline__ unsigned char* arg_ws() { return *(unsigned char* const CAS*)(karg_base() + 168); }
static_assert(sizeof(Args) == 184, "Args layout");

template <bool TILED> __device__ __forceinline__ void cvt_item(const float* W, int K, int N, bf16* WT, int kb, int nb, int drow0, const float* ks, int ksmask, float scal, LAS float* scr, int lane) {
    const int k0 = kb * 64, n0 = nb * 64, q = lane >> 4, c4 = (lane & 15) * 4;
    f32x4 v[16];
#pragma unroll
    for (int i = 0; i < 16; ++i) v[i] = *(const GAS f32x4*)(W + (size_t)(k0 + 4 * i + q) * N + n0 + c4);
    const int c = lane & 7;
    f32x4 s0 = {scal, scal, scal, scal}, s1 = s0;
    if (ks) { const int kk = (k0 + 8 * c) & ksmask; s0 = *(const f32x4*)(ks + kk) * scal; s1 = *(const f32x4*)(ks + kk + 4) * scal; }
#pragma unroll
    for (int i = 0; i < 16; ++i) { LAS float* d = scr + (4 * i + q) * 65 + c4; d[0] = v[i][0]; d[1] = v[i][1]; d[2] = v[i][2]; d[3] = v[i][3]; }
    LDS_WAIT(); asm volatile("" ::: "memory");
#pragma unroll
    for (int j = 0; j < 8; ++j) { const int n = (lane >> 3) + 8 * j; const LAS float* s = scr + (8 * c) * 65 + n;
        v4u o; o.x = pk2(s[0 * 65] * s0[0], s[1 * 65] * s0[1]); o.y = pk2(s[2 * 65] * s0[2], s[3 * 65] * s0[3]); o.z = pk2(s[4 * 65] * s1[0], s[5 * 65] * s1[1]); o.w = pk2(s[6 * 65] * s1[2], s[7 * 65] * s1[3]);
        const int dr = drow0 + n;
        bf16* dst = TILED ? WT + (size_t)(dr >> 8) * 256 * K + (size_t)kb * 16384 + (dr & 255) * 64 + 8 * c : WT + (size_t)dr * K + k0 + 8 * c;
        *(GAS v4u*)dst = o; }
    LDS_WAIT(); asm volatile("" ::: "memory");
}
__device__ __forceinline__ bool cvt_matrix(int& r, const float* W, int K, int N, bf16* WT, int mode, const float* ks, int ksmask, float scal, int scal_n, LAS float* scr, int lane) {
    const int nblk = N / 64, items = (K / 64) * nblk;
    if (r >= items) { r -= items; return false; }
    const int kb = r / nblk, nb = r % nblk, n0 = nb * 64; int d0 = n0;
    if (mode == 1) { const int isup = n0 >= DFF ? 1 : 0, j = n0 - isup * DFF; d0 = (j >> 7) * 256 + isup * 128 + (j & 127); }
    else if (mode == 2 && n0 < 2048) { const int head = n0 >> 8, comp = (n0 >> 7) & 1, half = (n0 >> 6) & 1; d0 = head * 256 + half * 128 + comp * 64; }
    if (mode == 3) cvt_item<true>(W, K, N, WT, kb, nb, d0, ks, ksmask, n0 < scal_n ? scal : 1.0f, scr, lane);
    else cvt_item<false>(W, K, N, WT, kb, nb, d0, ks, ksmask, n0 < scal_n ? scal : 1.0f, scr, lane);
    return true;
}

namespace hg {
constexpr int QS_OFF = 0, KS_OFF = 8704, KH_OFF = 17408, VS_OFF = 26112, AT_OFF = 34816, DEC_OFF = 36864, RED_OFF = 37376, BUF = 38400;
constexpr int QPITCH = 272;
struct Stage { f32x4 b0, b1, l0, l1, p0, p1; v4u q, v; };
__device__ __forceinline__ void prefetch(Stage& S, const float* Bc, const bf16* Qb, const bf16* Vb, size_t off, size_t off31, size_t offp) {
    S.b0 = *(const f32x4*)(Bc + off); S.b1 = *(const f32x4*)(Bc + off + 4); S.l0 = *(const f32x4*)(Bc + off31); S.l1 = *(const f32x4*)(Bc + off31 + 4);
    S.q = *(const v4u*)(Qb + off); S.p0 = *(const f32x4*)(Bc + offp); S.p1 = *(const f32x4*)(Bc + offp + 4); S.v = *(const v4u*)(Vb + off);
}
__device__ __forceinline__ void stage(const Stage& S, int t, int c, LAS unsigned char* B) {
    const float b[8] = {S.b0[0], S.b0[1], S.b0[2], S.b0[3], S.b1[0], S.b1[1], S.b1[2], S.b1[3]};
    const float bl[8] = {S.l0[0], S.l0[1], S.l0[2], S.l0[3], S.l1[0], S.l1[1], S.l1[2], S.l1[3]};
    const float qf[8] = {bflo(S.q.x), bfhi(S.q.x), bflo(S.q.y), bfhi(S.q.y), bflo(S.q.z), bfhi(S.q.z), bflo(S.q.w), bfhi(S.q.w)};
    const float pz = t > 0 ? 1.0f : 0.0f;
    const float bp[8] = {S.p0[0] * pz, S.p0[1] * pz, S.p0[2] * pz, S.p0[3] * pz, S.p1[0] * pz, S.p1[1] * pz, S.p1[2] * pz, S.p1[3] * pz};
    float kf[8];
#pragma unroll
    for (int j = 0; j < 8; ++j) kf[j] = 1.0f - __builtin_amdgcn_exp2f(b[j] - bp[j]);
    float qs[8], ks[8], kh[8];
#pragma unroll
    for (int j = 0; j < 8; ++j) { qs[j] = qf[j] * __builtin_amdgcn_exp2f(b[j]); ks[j] = kf[j] * __builtin_amdgcn_exp2f(fminf(-b[j], 115.f)); kh[j] = kf[j] * __builtin_amdgcn_exp2f(bl[j] - b[j]); }
    v4u w;
    w.x = pk2(qs[0], qs[1]); w.y = pk2(qs[2], qs[3]); w.z = pk2(qs[4], qs[5]); w.w = pk2(qs[6], qs[7]); *(LAS v4u*)(B + QS_OFF + t * QPITCH + c * 16) = w;
    w.x = pk2(ks[0], ks[1]); w.y = pk2(ks[2], ks[3]); w.z = pk2(ks[4], ks[5]); w.w = pk2(ks[6], ks[7]); *(LAS v4u*)(B + KS_OFF + t * QPITCH + c * 16) = w;
    w.x = pk2(kh[0], kh[1]); w.y = pk2(kh[2], kh[3]); w.z = pk2(kh[4], kh[5]); w.w = pk2(kh[6], kh[7]); *(LAS v4u*)(B + KH_OFF + t * QPITCH + c * 16) = w;
    *(LAS v4u*)(B + VS_OFF + t * QPITCH + c * 16) = S.v;
    if (t == 31) { float d[8];
#pragma unroll
        for (int j = 0; j < 8; ++j) d[j] = __builtin_amdgcn_exp2f(bl[j]);
        *(LAS f32x4*)(B + DEC_OFF + c * 32) = (f32x4){d[0], d[1], d[2], d[3]}; *(LAS f32x4*)(B + DEC_OFF + c * 32 + 16) = (f32x4){d[4], d[5], d[6], d[7]}; }
}
#define HG_TR(dst, addr, off) asm volatile("ds_read_b64_tr_b16 %0, %1 offset:%2" : "=&v"(dst) : "v"(addr), "i"(off) : "memory")
__device__ __forceinline__ void scan_phase(LAS unsigned char* lds, const bf16* Qin, bf16* OUT, const float* Bc, const bf16* Vb, const bf16* SGb, int G, int vcu, const int w) {
    const int lane = fresh_lane(), tid = w * 64 + lane, l15 = lane & 15, q4 = lane >> 4;
    const int st = tid >> 4, sc = tid & 15;
    for (int unit = vcu; unit < 256; unit += G) {
        const int b = unit >> 4, h = unit & 15;
        const size_t base = (size_t)b * SEQ * DM + h * 128;
        __syncthreads();
        if (tid < 128) { const int bufi = tid >> 6, r = (tid >> 2) & 15, part = tid & 3; *(LAS u64*)(lds + bufi * BUF + AT_OFF + r * 64 + 32 + part * 8) = 0ull; }
        f32x4 S[8];
#pragma unroll
        for (int j = 0; j < 8; ++j) S[j] = (f32x4){0.f, 0.f, 0.f, 0.f};
        Stage P;
        prefetch(P, Bc, Qin, Vb, base + (size_t)st * DM + sc * 8, base + (size_t)31 * DM + sc * 8, base + (size_t)(st > 0 ? st - 1 : 0) * DM + sc * 8);
        stage(P, st, sc, lds);
        LDS_WAIT(); __syncthreads();
        for (int c = 0; c < 64; ++c) {
            LAS unsigned char* B = lds + (c & 1) * BUF;
            const size_t crow0 = base + (size_t)c * 32 * DM;
            if (c + 1 < 64) prefetch(P, Bc, Qin, Vb, crow0 + (size_t)(32 + st) * DM + sc * 8, crow0 + (size_t)63 * DM + sc * 8, crow0 + (size_t)(32 + (st > 0 ? st - 1 : 0)) * DM + sc * 8);
            const v2u sg0 = *(const v2u*)(SGb + crow0 + (size_t)l15 * DM + 16 * w + 4 * q4);
            const v2u sg1 = *(const v2u*)(SGb + crow0 + (size_t)(l15 + 16) * DM + 16 * w + 4 * q4);
            if (w < 3) { const int tt = w > 0 ? 1 : 0, stl = w > 1 ? 1 : 0; f32x4 a = {0.f, 0.f, 0.f, 0.f};
#pragma unroll
                for (int j = 0; j < 4; ++j) { const bf16x8 qa = *(const LAS bf16x8*)(B + QS_OFF + (16 * tt + l15) * QPITCH + (32 * j + 8 * q4) * 2);
                    const bf16x8 kb = *(const LAS bf16x8*)(B + KS_OFF + (16 * stl + l15) * QPITCH + (32 * j + 8 * q4) * 2);
                    a = __builtin_amdgcn_mfma_f32_16x16x32_bf16(qa, kb, a, 0, 0, 0); }
#pragma unroll
                for (int i = 0; i < 4; ++i) { const int t = 16 * tt + 4 * q4 + i, s_ = 16 * stl + l15; const float v = s_ <= t ? a[i] : 0.f;
                    *(LAS unsigned short*)(B + AT_OFF + t * 64 + s_ * 2) = (unsigned short)pk2(v, 0.f); } }
            f32x4 o0 = {0.f, 0.f, 0.f, 0.f}, o1 = {0.f, 0.f, 0.f, 0.f};
#pragma unroll
            for (int j = 0; j < 4; ++j) { v4u sw; sw.x = pk2(S[2 * j][0], S[2 * j][1]); sw.y = pk2(S[2 * j][2], S[2 * j][3]); sw.z = pk2(S[2 * j + 1][0], S[2 * j + 1][1]); sw.w = pk2(S[2 * j + 1][2], S[2 * j + 1][3]);
                const bf16x8 sa = __builtin_bit_cast(bf16x8, sw);
                const LAS unsigned char* qp = B + QS_OFF + l15 * QPITCH + (32 * j + 4 * q4) * 2;
                const v2u a0 = *(const LAS v2u*)qp, a1 = *(const LAS v2u*)(qp + 32), c0 = *(const LAS v2u*)(qp + 16 * QPITCH), c1 = *(const LAS v2u*)(qp + 16 * QPITCH + 32);
                const v4u f0 = {a0.x, a0.y, a1.x, a1.y}, f1 = {c0.x, c0.y, c1.x, c1.y};
                o0 = __builtin_amdgcn_mfma_f32_16x16x32_bf16(sa, __builtin_bit_cast(bf16x8, f0), o0, 0, 0, 0);
                o1 = __builtin_amdgcn_mfma_f32_16x16x32_bf16(sa, __builtin_bit_cast(bf16x8, f1), o1, 0, 0, 0); }
            const unsigned trb = (unsigned)(uintptr_t)B + (8 * q4 + (l15 >> 2)) * QPITCH + (l15 & 3) * 8;
            s16x4 vlo, vhi;
            HG_TR(vlo, trb + VS_OFF + 32 * w, 0); HG_TR(vhi, trb + VS_OFF + 32 * w, 4 * QPITCH);
            LDS_WAIT(); __syncthreads(); __builtin_amdgcn_sched_barrier(0);
            const bf16x8 vt = (bf16x8){vlo[0], vlo[1], vlo[2], vlo[3], vhi[0], vhi[1], vhi[2], vhi[3]};
            { const bf16x8 at0 = *(const LAS bf16x8*)(B + AT_OFF + l15 * 64 + q4 * 16), at1 = *(const LAS bf16x8*)(B + AT_OFF + (l15 + 16) * 64 + q4 * 16);
              o0 = __builtin_amdgcn_mfma_f32_16x16x32_bf16(vt, at0, o0, 0, 0, 0);
              o1 = __builtin_amdgcn_mfma_f32_16x16x32_bf16(vt, at1, o1, 0, 0, 0); }
            { float p0 = (o0[0] * o0[0] + o0[1] * o0[1]) + (o0[2] * o0[2] + o0[3] * o0[3]), p1 = (o1[0] * o1[0] + o1[1] * o1[1]) + (o1[2] * o1[2] + o1[3] * o1[3]);
              p0 += __shfl_xor(p0, 16); p0 += __shfl_xor(p0, 32); p1 += __shfl_xor(p1, 16); p1 += __shfl_xor(p1, 32);
              if (q4 == 0) { *(LAS float*)(B + RED_OFF + (w * 32 + l15) * 4) = p0; *(LAS float*)(B + RED_OFF + (w * 32 + 16 + l15) * 4) = p1; } }
#pragma unroll
            for (int jp = 0; jp < 4; ++jp) { s16x4 a0, a1, c0, c1;
                HG_TR(a0, trb + KH_OFF, (2 * jp) * 32); HG_TR(a1, trb + KH_OFF, (2 * jp) * 32 + 4 * QPITCH); HG_TR(c0, trb + KH_OFF, (2 * jp + 1) * 32); HG_TR(c1, trb + KH_OFF, (2 * jp + 1) * 32 + 4 * QPITCH);
                const f32x4 d0 = *(const LAS f32x4*)(B + DEC_OFF + (16 * (2 * jp) + 4 * q4) * 4), d1 = *(const LAS f32x4*)(B + DEC_OFF + (16 * (2 * jp + 1) + 4 * q4) * 4);
                LDS_WAIT(); __builtin_amdgcn_sched_barrier(0);
                S[2 * jp] = __builtin_amdgcn_mfma_f32_16x16x32_bf16((bf16x8){a0[0], a0[1], a0[2], a0[3], a1[0], a1[1], a1[2], a1[3]}, vt, S[2 * jp] * d0, 0, 0, 0);
                S[2 * jp + 1] = __builtin_amdgcn_mfma_f32_16x16x32_bf16((bf16x8){c0[0], c0[1], c0[2], c0[3], c1[0], c1[1], c1[2], c1[3]}, vt, S[2 * jp + 1] * d1, 0, 0, 0); }
            if (c + 1 < 64) stage(P, st, sc, lds + ((c + 1) & 1) * BUF);
            LDS_WAIT(); __syncthreads();
            float s0 = 0.f, s1 = 0.f;
#pragma unroll
            for (int ww = 0; ww < 8; ++ww) { s0 += *(const LAS float*)(B + RED_OFF + (ww * 32 + l15) * 4); s1 += *(const LAS float*)(B + RED_OFF + (ww * 32 + 16 + l15) * 4); }
            const float r0 = rsqrtf(s0 * (1.0f / 128.0f) + NORM_EPS), r1 = rsqrtf(s1 * (1.0f / 128.0f) + NORM_EPS);
            v2u w0, w1;
            w0.x = pk2(o0[0] * r0 * bflo(sg0.x), o0[1] * r0 * bfhi(sg0.x)); w0.y = pk2(o0[2] * r0 * bflo(sg0.y), o0[3] * r0 * bfhi(sg0.y));
            w1.x = pk2(o1[0] * r1 * bflo(sg1.x), o1[1] * r1 * bfhi(sg1.x)); w1.y = pk2(o1[2] * r1 * bflo(sg1.y), o1[3] * r1 * bfhi(sg1.y));
            *(v2u*)(OUT + crow0 + (size_t)l15 * DM + 16 * w + 4 * q4) = w0;
            *(v2u*)(OUT + crow0 + (size_t)(l15 + 16) * DM + 16 * w + 4 * q4) = w1;
        }
    }
}
#undef HG_TR
}

__global__ void __launch_bounds__(NWAVES * 64, 2) yoco_fwd(Args args) {
    extern __shared__ __attribute__((aligned(16))) unsigned char lds_raw[];
    LAS unsigned char* lds = (LAS unsigned char*)lds_raw;
    volatile LAS unsigned* MISC = (volatile LAS unsigned*)(lds + MISC_OFF);
    const int wave = __builtin_amdgcn_readfirstlane((int)threadIdx.x >> 6);
    const int G = gridDim.x, bx = blockIdx.x, vcu = (G % 8 == 0) ? (bx % 8) * (G / 8) + bx / 8 : bx;
    for (int u = wave * 64 + fresh_lane(); u < (LDS_BYTES - LDSCTL_OFF) / 4; u += NWAVES * 64) ((LAS unsigned*)(lds + LDSCTL_OFF))[u] = 0u;
    __syncthreads();
    XcdBarrier bar; bar.bar = (unsigned*)(arg_ws() + WS_CTL) + CW_BAR; bar.x = 0; bar.st = nullptr;
    if (MK_N_LAUNCHES == 1) bar = xcd_barrier_post((unsigned*)(arg_ws() + WS_CTL) + CW_BAR, MISC + 8, wave);
#define GRID_BAR() do { if (MK_N_LAUNCHES == 1) xcd_barrier(bar, wave); } while (0)
    const int lo = args.ph_lo, hi = args.ph_hi;
#define IN(k) (lo <= (k) && (k) < hi)
#define BOTH(k) (IN(k) && IN((k) + 1))
#define STAT(i) ((float*)(ws + WS_STATS) + (size_t)(i) * 8 * MTOK)
#define REDP ((LAS float*)(lds + RED_OFF))
#define WPTR(off) ((bf16*)(ws + WS_W + (off)))
#define BIGP(T, off) ((T*)(ws + WS_BIG + (off)))
#define HB1P ((bf16*)(ws + WS_HB1))
#define HB2P ((bf16*)(ws + WS_HB2))
#define ROPE_COS ((float*)(ws + WS_TAB))
#define ROPE_SIN ((float*)(ws + WS_TAB + 512 * 1024))
#define LBTAB ((float*)(ws + WS_TAB + MiB))
#define LAMP ((float*)(ws + WS_TAB + MiB + 16384))
#define FNTAB ((float*)(ws + WS_TAB + MiB + 32768))

    if (IN(0)) {
        for (int rep_ = 0; rep_ < (PROBE_DUP == 0 ? 2 : 1); ++rep_) {
        unsigned char* ws = arg_ws();
        const int lane = fresh_lane(), tid = wave * 64 + lane;
        LAS float* scr = (LAS float*)(lds + RING_OFF + wave * 16640);
        const int gw = vcu * NWAVES + wave, NGW = G * NWAVES;
        constexpr int ITEMS = (4 * DM * NGU + 4 * DFF * DM + DM * 8192 + 5 * DM * DM + DM * 4096 + 2 * 256 * DM) / 4096;
        for (int it = gw; it < ITEMS; it += NGW) {
            int r = it; bool done = false;
#pragma unroll 1
            for (int f = 0; f < 4 && !done; ++f) done = cvt_matrix(r, arg_in(3) + (size_t)f * DM * NGU, DM, NGU, WPTR(W_GU + (size_t)f * 44 * MiB), 1, arg_in(2) + f * DM, DM - 1, 1.0f, 0, scr, lane);
#pragma unroll 1
            for (int f = 0; f < 4 && !done; ++f) done = cvt_matrix(r, arg_in(4) + (size_t)f * DFF * DM, DFF, DM, WPTR(W_DN + (size_t)f * 22 * MiB), 3, nullptr, 0, 1.0f, 0, scr, lane);
            if (!done) done = cvt_matrix(r, arg_in(6), DM, 8192, WPTR(W_HIN), 0, arg_in(5), DM - 1, QSCALE, 2048, scr, lane);
            if (!done) done = cvt_matrix(r, arg_in(9), DM, DM, WPTR(W_HOUT), 0, arg_in(8), 127, 1.0f, 0, scr, lane);
            if (!done) done = cvt_matrix(r, arg_in(11), DM, 4096, WPTR(W_KV), 2, arg_in(10), DM - 1, 1.0f, 0, scr, lane);
            if (!done) done = cvt_matrix(r, arg_in(12), DM, DM, WPTR(W_Q), 2, arg_in(5) + DM, DM - 1, 1.0f, 0, scr, lane);
            if (!done) done = cvt_matrix(r, arg_in(15), DM, DM, WPTR(W_AO), 0, arg_in(14), 255, 1.0f - LAMBDA_INIT, DM, scr, lane);
#pragma unroll 1
            for (int f = 0; f < 2 && !done; ++f) done = cvt_matrix(r, arg_in(17) + (size_t)f * DM * DM, DM, DM, WPTR(W_PG + (size_t)f * 8 * MiB), 0, arg_in(16) + f * DM, DM - 1, 1.0f, 0, scr, lane);
#pragma unroll 1
            for (int f = 0; f < 2 && !done; ++f) done = cvt_matrix(r, arg_in(18) + (size_t)f * 256 * DM, 256, DM, WPTR(W_PP + (size_t)f * MiB), 0, nullptr, 0, 1.0f, 0, scr, lane);
        }
        { const float* x = arg_in(0); bf16* HB1 = HB1P; float* st0 = STAT(0);
          for (int m = gw; m < MTOK; m += NGW) {
            const GAS f32x4* xr = (const GAS f32x4*)(x + (size_t)m * DM) + lane; GAS v2u* o8 = (GAS v2u*)(HB1 + (size_t)m * DM) + lane; float s = 0.f;
#pragma unroll
            for (int j = 0; j < 8; ++j) { const f32x4 v = xr[64 * j]; s += (v[0] * v[0] + v[1] * v[1]) + (v[2] * v[2] + v[3] * v[3]); v2u o; o.x = pk2(v[0], v[1]); o.y = pk2(v[2], v[3]); o8[64 * j] = o; }
            s = wave_sum(s);
            if (lane < 8) st0[(size_t)lane * MTOK + m] = lane == 0 ? s : 0.f;
          } }
        { const float* pin = arg_in(1); bf16* PB = (bf16*)(ws + WS_PB); const size_t n8 = (size_t)2 * MTOK * 256 / 8;
          for (size_t i = (size_t)bx * 512 + tid; i < n8; i += (size_t)G * 512) { const f32x4 a = *(const f32x4*)(pin + i * 8), b = *(const f32x4*)(pin + i * 8 + 4);
              v4u o; o.x = pk2(a[0], a[1]); o.y = pk2(a[2], a[3]); o.z = pk2(b[0], b[1]); o.w = pk2(b[2], b[3]); *(v4u*)(PB + i * 8) = o; } }
        { float* rope_cos = ROPE_COS; float* rope_sin = ROPE_SIN;
          for (int e = bx * 512 + tid; e < SEQ * 64; e += G * 512) {
            const int pos = e >> 6, i = e & 63;
            double f = 1.0; for (int k = 0; k < i; ++k) f *= 0.8659643233600653;
            const float ang = (float)pos * (float)f;
            const double a = (double)ang; const double kq = __builtin_rint(a * 0.63661977236758134); const double rr = (a - kq * 1.5707963267948966) - kq * 6.123233995736766e-17;
            const double r2 = rr * rr;
            double sp = 1.0 / 6227020800.0; sp = sp * r2 - 1.0 / 39916800.0; sp = sp * r2 + 1.0 / 362880.0; sp = sp * r2 - 1.0 / 5040.0; sp = sp * r2 + 1.0 / 120.0; sp = sp * r2 - 1.0 / 6.0; sp = sp * r2 + 1.0; sp *= rr;
            double cp = 1.0 / 87178291200.0; cp = -cp * r2 + 1.0 / 479001600.0; cp = cp * r2 - 1.0 / 3628800.0; cp = cp * r2 + 1.0 / 40320.0; cp = cp * r2 - 1.0 / 720.0; cp = cp * r2 + 1.0 / 24.0; cp = cp * r2 - 0.5; cp = cp * r2 + 1.0;
            const int qd = ((int)kq) & 3;
            const double sv = qd == 0 ? sp : (qd == 1 ? cp : (qd == 2 ? -sp : -cp)), cv = qd == 0 ? cp : (qd == 1 ? -sp : (qd == 2 ? -cp : sp));
            rope_cos[e] = (float)cv; rope_sin[e] = (float)sv;
          } }
        { const float* lbin = arg_in(7); const float* fn = arg_in(19); float* lbtab = LBTAB; float* fnt = FNTAB;
          for (int e = bx * 512 + tid; e < DM; e += G * 512) { const float a0 = lbin[e], a1 = lbin[DM + e]; lbtab[e] = 1.0f / (1.0f + expf(a1 - a0)); fnt[e] = fn[e]; } }
        if (bx == 0 && wave == 0) { const float* lam = arg_in(13); float d1 = lam[lane] * lam[128 + lane] + lam[64 + lane] * lam[192 + lane], d2 = lam[256 + lane] * lam[384 + lane] + lam[320 + lane] * lam[448 + lane];
            d1 = wave_sum(d1); d2 = wave_sum(d2); if (lane == 0) LAMP[0] = expf(d1) - expf(d2) + LAMBDA_INIT; }
        }
        if (BOTH(0)) GRID_BAR();
    }

#define RSTAB ((const LAS float*)(lds + RSTAB_OFF))
#define FILL_RSTD(i) fill_rstd_table((LAS float*)(lds + RSTAB_OFF), STAT(i), bx, wave)
#define GEMM_PHASE_T(EpiT, Eobj, Aptr, Bptr, Nn, Kk) do { pg8::Gemm g_{(const bf16*)(Aptr), (const bf16*)(Bptr), MTOK, (Nn), (Kk)}; pg8::StaticOrder S_; S_.init(MTOK, (Nn), G, bx); \
        pg8::gemm_phase<EpiT, pg8::StaticOrder, true, true, true, true>(lds + RING_OFF, g_, S_, Eobj, wave); } while (0)
#define GEMM_PHASE(EpiT, Eobj, Aptr, Bptr, Nn, Kk) do { pg8::Gemm g_{(const bf16*)(Aptr), (const bf16*)(Bptr), MTOK, (Nn), (Kk)}; pg8::StaticOrder S_; S_.init(MTOK, (Nn), G, bx); \
        pg8::gemm_phase<EpiT, pg8::StaticOrder, true, true>(lds + RING_OFF, g_, S_, Eobj, wave); } while (0)

    if (IN(1)) { unsigned char* ws = arg_ws(); FILL_RSTD(0); EpiGU E{BIGP(bf16, BIG_HID), RSTAB}; if (PROBE_DUP == 1) GEMM_PHASE(EpiGU, E, HB1P, WPTR(W_GU + 0 * 44 * MiB), NGU, DM); GEMM_PHASE(EpiGU, E, HB1P, WPTR(W_GU + 0 * 44 * MiB), NGU, DM); if (PROBE_DUP == 100) { for (int rep_ = 0; rep_ < 20; ++rep_) GRID_BAR(); } if (BOTH(1)) GRID_BAR(); }
    if (IN(2)) { unsigned char* ws = arg_ws(); EpiRes<true> E{arg_in(0), HB1P, STAT(1), 0.5f, REDP}; GEMM_PHASE_T(EpiRes<true>, E, BIGP(bf16, BIG_HID), WPTR(W_DN + 0 * 22 * MiB), DM, DFF);
        if (BOTH(2)) GRID_BAR(); }
    if (IN(3)) { unsigned char* ws = arg_ws(); FILL_RSTD(1); EpiHgIn E{BIGP(bf16, BIG_HQ), BIGP(float, BIG_HLF), BIGP(bf16, BIG_HV), BIGP(bf16, BIG_HSG), RSTAB, LBTAB};
        if (PROBE_DUP == 3) GEMM_PHASE(EpiHgIn, E, HB1P, WPTR(W_HIN), 8192, DM);
        GEMM_PHASE(EpiHgIn, E, HB1P, WPTR(W_HIN), 8192, DM); if (BOTH(3)) GRID_BAR(); }
    if (IN(4)) { unsigned char* ws = arg_ws();
        hg::scan_phase(lds + RING_OFF, BIGP(const bf16, BIG_HQ), BIGP(bf16, BIG_HQ), BIGP(const float, BIG_HLF), BIGP(const bf16, BIG_HV), BIGP(const bf16, BIG_HSG), G, vcu, wave); if (BOTH(4)) GRID_BAR(); }
    if (IN(5)) { unsigned char* ws = arg_ws(); EpiRes<false> E{HB1P, HB1P, STAT(2), 1.0f, REDP}; GEMM_PHASE(EpiRes<false>, E, BIGP(bf16, BIG_HQ), WPTR(W_HOUT), DM, DM); if (BOTH(5)) GRID_BAR(); }
    if (IN(6)) { unsigned char* ws = arg_ws(); FILL_RSTD(2); EpiGU E{BIGP(bf16, BIG_HID), RSTAB}; GEMM_PHASE(EpiGU, E, HB1P, WPTR(W_GU + 1 * 44 * MiB), NGU, DM); if (BOTH(6)) GRID_BAR(); }
    if (IN(7)) { unsigned char* ws = arg_ws();
                 { EpiRes<false> E{HB1P, HB1P, STAT(3), 0.5f, REDP}; GEMM_PHASE_T(EpiRes<false>, E, BIGP(bf16, BIG_HID), WPTR(W_DN + 1 * 22 * MiB), DM, DFF); }
                 { EpiPlain E{BIGP(bf16, BIG_PP)}; GEMM_PHASE(EpiPlain, E, ws + WS_PB, WPTR(W_PP), DM, 256); }
                 if (BOTH(7)) GRID_BAR(); }
    if (IN(8)) { unsigned char* ws = arg_ws(); FILL_RSTD(3); EpiPleG E{HB1P, HB2P, STAT(4), RSTAB, BIGP(const bf16, BIG_PP), REDP}; GEMM_PHASE(EpiPleG, E, HB1P, WPTR(W_PG), DM, DM); if (BOTH(8)) GRID_BAR(); }
    if (IN(9)) { unsigned char* ws = arg_ws();
                 FILL_RSTD(4);
                 { EpiRope E{BIGP(bf16, BIG_KR), BIGP(bf16, BIG_VV), 8, RSTAB, ROPE_COS, ROPE_SIN}; if (PROBE_DUP == 9) GEMM_PHASE(EpiRope, E, HB2P, WPTR(W_KV), 4096, DM); GEMM_PHASE(EpiRope, E, HB2P, WPTR(W_KV), 4096, DM); }
                 { EpiGU E{BIGP(bf16, BIG_HID), RSTAB}; GEMM_PHASE(EpiGU, E, HB2P, WPTR(W_GU + 2 * 44 * MiB), NGU, DM); }
                 if (BOTH(9)) GRID_BAR(); }
    if (IN(10)) { unsigned char* ws = arg_ws(); EpiRes<false> E{HB2P, HB1P, STAT(5), 0.5f, REDP}; GEMM_PHASE_T(EpiRes<false>, E, BIGP(bf16, BIG_HID), WPTR(W_DN + 2 * 22 * MiB), DM, DFF); if (BOTH(10)) GRID_BAR(); }
    if (IN(11)) { unsigned char* ws = arg_ws(); FILL_RSTD(5); EpiRope E{BIGP(bf16, BIG_QR), BIGP(bf16, BIG_QR), 8, RSTAB, ROPE_COS, ROPE_SIN}; if (PROBE_DUP == 11) GEMM_PHASE(EpiRope, E, HB1P, WPTR(W_Q), DM, DM); GEMM_PHASE(EpiRope, E, HB1P, WPTR(W_Q), DM, DM); if (BOTH(11)) GRID_BAR(); }
    if (IN(12)) { unsigned char* ws = arg_ws();
                  att::attn_phase((char*)lds_raw + RING_OFF, BIGP(const bf16, BIG_QR), BIGP(const bf16, BIG_KR), BIGP(const bf16, BIG_VV), BIGP(bf16, BIG_O1), HB2P, LAMP[0], G, bx, wave);
                  if (BOTH(12)) GRID_BAR(); }
    if (IN(13)) { }
    if (IN(14)) { unsigned char* ws = arg_ws(); EpiRes<false> E{HB1P, HB1P, STAT(6), 1.0f, REDP}; GEMM_PHASE(EpiRes<false>, E, HB2P, WPTR(W_AO), DM, DM); if (BOTH(14)) GRID_BAR(); }
    if (IN(15)) { unsigned char* ws = arg_ws(); FILL_RSTD(6); EpiGU E{BIGP(bf16, BIG_HID), RSTAB}; GEMM_PHASE(EpiGU, E, HB1P, WPTR(W_GU + 3 * 44 * MiB), NGU, DM); if (BOTH(15)) GRID_BAR(); }
    if (IN(16)) { unsigned char* ws = arg_ws();
                  { EpiRes<false> E{HB1P, HB1P, STAT(7), 0.5f, REDP}; GEMM_PHASE_T(EpiRes<false>, E, BIGP(bf16, BIG_HID), WPTR(W_DN + 3 * 22 * MiB), DM, DFF); }
                  { EpiPlain E{BIGP(bf16, BIG_PP)}; GEMM_PHASE(EpiPlain, E, ws + WS_PB + (size_t)MTOK * 256 * 2, WPTR(W_PP + MiB), DM, 256); }
                  if (BOTH(16)) GRID_BAR(); }
    if (IN(17)) { unsigned char* ws = arg_ws(); FILL_RSTD(7); EpiPleG E{HB1P, HB2P, STAT(8), RSTAB, BIGP(const bf16, BIG_PP), REDP}; GEMM_PHASE(EpiPleG, E, HB1P, WPTR(W_PG + 8 * MiB), DM, DM); if (BOTH(17)) GRID_BAR(); }
    if (IN(18)) {
        unsigned char* ws = arg_ws(); float* out = arg_out(); const bf16* HB2 = HB2P;
        const int lane = fresh_lane();
        const float* gn = FNTAB; const int gw = vcu * NWAVES + wave, NGW = G * NWAVES;
        unsigned poison = 0;
        if (MK_N_LAUNCHES == 1) poison = __hip_atomic_load((unsigned*)(ws + WS_CTL) + CW_BAR + XB_TMO, RLX_AGENT);
        const float* st8 = STAT(8);
        for (int m = gw; m < MTOK; m += NGW) { const float rs = poison ? __builtin_nanf("") : stat_rstd(st8, m);
#pragma unroll
            for (int j = 0; j < 4; ++j) { const int c = lane * 8 + 512 * j; const v4u r = *(const v4u*)(HB2 + (size_t)m * DM + c);
                const f32x4 g0 = *(const f32x4*)(gn + c), g1 = *(const f32x4*)(gn + c + 4);
                const f32x4 o0 = {bflo(r.x) * rs * g0[0], bfhi(r.x) * rs * g0[1], bflo(r.y) * rs * g0[2], bfhi(r.y) * rs * g0[3]};
                const f32x4 o1 = {bflo(r.z) * rs * g1[0], bfhi(r.z) * rs * g1[1], bflo(r.w) * rs * g1[2], bfhi(r.w) * rs * g1[3]};
                *(f32x4*)(out + (size_t)m * DM + c) = o0; *(f32x4*)(out + (size_t)m * DM + c + 4) = o1; } }
    }
#undef IN
#undef BOTH
}

extern "C" void kernel_launch(void* const* d_in, const int* in_sizes, int n_in, void* d_out, int out_size, void* d_ws, size_t ws_size, hipStream_t stream) {
    static int grid = 0;
    if (grid == 0) {
        if (n_in != 20 || in_sizes[0] != MTOK * DM || out_size != MTOK * DM || ws_size < WS_END) { fprintf(stderr, "kernel_launch: unexpected shapes (n_in %d, in0 %d, out %d, ws %zu < %zu)\n", n_in, n_in > 0 ? in_sizes[0] : -1, out_size, ws_size, (size_t)WS_END); grid = -1; return; }
        int dev = 0, cus = 0, per_cu = 0;
        if (hipGetDevice(&dev) != hipSuccess || hipDeviceGetAttribute(&cus, hipDeviceAttributeMultiprocessorCount, dev) != hipSuccess) { grid = -1; return; }
        if (hipFuncSetAttribute((const void*)yoco_fwd, hipFuncAttributeMaxDynamicSharedMemorySize, LDS_BYTES) != hipSuccess) { fprintf(stderr, "kernel_launch: hipFuncSetAttribute failed\n"); grid = -1; return; }
        if (hipOccupancyMaxActiveBlocksPerMultiprocessor(&per_cu, (const void*)yoco_fwd, NWAVES * 64, LDS_BYTES) != hipSuccess || per_cu < 1) fprintf(stderr, "kernel_launch: occupancy query says %d\n", per_cu);
        (void)hipGetLastError();
        grid = cus > 256 ? 256 : (cus / 8) * 8;
        if (grid < 8) { fprintf(stderr, "kernel_launch: device has %d CUs; at least 8 are needed\n", cus); grid = -1; return; }
    }
    if (grid < 0) return;
    (void)hipMemsetAsync((char*)d_ws + WS_CTL, 0, CTL_ZERO_BYTES, stream);
    Args a{};
    for (int i = 0; i < 20; ++i) a.in[i] = (const float*)d_in[i];
    a.out = (float*)d_out; a.ws = (unsigned char*)d_ws;
#if MK_N_LAUNCHES == 1
    a.ph_lo = 0; a.ph_hi = NPHASE;
    hipLaunchKernelGGL(yoco_fwd, dim3(grid), dim3(NWAVES * 64), LDS_BYTES, stream, a);
#else
    for (int k = 0; k < NPHASE; ++k) { a.ph_lo = k; a.ph_hi = k + 1; hipLaunchKernelGGL(yoco_fwd, dim3(grid), dim3(NWAVES * 64), LDS_BYTES, stream, a); }
#endif
}
```
